# Optimizing an MI355X kernel written in HIP

```python
import jax, jax.numpy as jnp
from jax import lax
import numpy as np

D_MODEL = 2048
BATCH = 16
SEQ = 2048
DEPTH = 1

MIX_WIDTH = D_MODEL
GMLP_WIDTH = MIX_WIDTH // 2
GMLP_GROUP_DIM = 128
GMLP_GROUPS = GMLP_WIDTH // GMLP_GROUP_DIM
GMLP_CHUNK = 128
V_HEAD_DIM = 128
MLA_HEADS = (MIX_WIDTH - GMLP_WIDTH) // V_HEAD_DIM
QK_NOPE_DIM = 128
QK_ROPE_DIM = 64
QK_HEAD_DIM = QK_NOPE_DIM + QK_ROPE_DIM
Q_LORA_RANK = 512
KV_LORA_RANK = 512
ROPE_THETA = 10000.0
ATTN_BLOCK = 128
IN_COLS = 2 * GMLP_WIDTH + Q_LORA_RANK + KV_LORA_RANK + QK_ROPE_DIM
D_FF = 5504
EPS = 1e-6

kernel_name = "hymba_macaron_gmlp_mla_layer"


def rmsnorm(x, g):
    x32 = x.astype(jnp.float32)
    y = x32 * lax.rsqrt(jnp.mean(x32 * x32, axis=-1, keepdims=True) + EPS)
    return (y * g.astype(jnp.float32)).astype(x.dtype)


def swiglu(x, w_gate, w_up, w_down):
    return (jax.nn.silu(x @ w_gate) * (x @ w_up)) @ w_down


def rope_tables(positions):
    half = QK_ROPE_DIM // 2
    inv_freq = 1.0 / (ROPE_THETA ** (jnp.arange(half, dtype=jnp.float32) / half))
    ang = positions.astype(jnp.float32)[..., None] * inv_freq
    return jnp.cos(ang)[:, :, None, :], jnp.sin(ang)[:, :, None, :]


def apply_rope(x, cos, sin):
    x1, x2 = jnp.split(x.astype(jnp.float32), 2, axis=-1)
    return jnp.concatenate([x1 * cos - x2 * sin, x2 * cos + x1 * sin], axis=-1).astype(x.dtype)


def gmlp_mixer(z, v_norm_g, w_s, b_s):
    B, S, _ = z.shape
    z = jax.nn.gelu(z, approximate=False)
    u, v = jnp.split(z, 2, axis=-1)
    v = rmsnorm(v, v_norm_g)
    n_chunks = S // GMLP_CHUNK
    v = v.reshape(B, n_chunks, GMLP_CHUNK, GMLP_GROUPS, GMLP_GROUP_DIM)
    w_causal = jnp.tril(w_s)
    mixed = jnp.einsum('gts,bcsgd->bctgd', w_causal, v) + b_s.T[None, None, :, :, None]
    return u * mixed.reshape(B, S, GMLP_WIDTH)


def mla_mixer(c_q, c_kv, k_rope, cos, sin, q_norm_g, w_q_up, kv_norm_g, w_kv_up,
              q_head_g, k_head_g):
    B, S, _ = c_q.shape
    q = (rmsnorm(c_q, q_norm_g) @ w_q_up).reshape(B, S, MLA_HEADS, QK_HEAD_DIM)
    kv = (rmsnorm(c_kv, kv_norm_g) @ w_kv_up).reshape(B, S, MLA_HEADS, QK_NOPE_DIM + V_HEAD_DIM)
    k_nope, v = jnp.split(kv, [QK_NOPE_DIM], axis=-1)
    k_r = jnp.broadcast_to(k_rope[:, :, None, :], (B, S, MLA_HEADS, QK_ROPE_DIM))
    k = jnp.concatenate([k_nope, k_r], axis=-1)
    q = rmsnorm(q, q_head_g)
    k = rmsnorm(k, k_head_g)
    q = jnp.concatenate([q[..., :QK_NOPE_DIM], apply_rope(q[..., QK_NOPE_DIM:], cos, sin)], axis=-1)
    k = jnp.concatenate([k[..., :QK_NOPE_DIM], apply_rope(k[..., QK_NOPE_DIM:], cos, sin)], axis=-1)
    scale = QK_HEAD_DIM ** -0.5
    outs = []
    for i in range(S // ATTN_BLOCK):
        q_blk = q[:, i * ATTN_BLOCK:(i + 1) * ATTN_BLOCK]
        kv_len = (i + 1) * ATTN_BLOCK
        s = jnp.einsum('bqhd,bkhd->bhqk', q_blk, k[:, :kv_len]).astype(jnp.float32) * scale
        q_pos = i * ATTN_BLOCK + jnp.arange(ATTN_BLOCK)
        mask = q_pos[:, None] >= jnp.arange(kv_len)[None, :]
        s = jnp.where(mask[None, None], s, jnp.float32(-1e30))
        p = jax.nn.softmax(s, axis=-1).astype(v.dtype)
        outs.append(jnp.einsum('bhqk,bkhd->bqhd', p, v[:, :kv_len]))
    return jnp.concatenate(outs, axis=1)


def setup_inputs(seed: int = 0) -> dict:
    key = jax.random.key(seed)
    ks = jax.random.split(key, 32)
    f32 = jnp.float32

    def normal(k, shape, scale):
        return jax.random.normal(k, shape, f32) * scale

    def gain(k, shape):
        return 1.0 + 0.05 * jax.random.normal(k, shape, f32)

    L = DEPTH
    x = jax.random.normal(ks[0], (BATCH, SEQ, D_MODEL), f32)
    offsets = jax.random.randint(ks[1], (BATCH, 1), 0, 4096, dtype=jnp.int32)
    positions = (offsets + jnp.arange(SEQ, dtype=jnp.int32)[None, :]).astype(jnp.int32)
    return {
        "x": x,
        "positions": positions,
        "ffn1_norm_g": gain(ks[2], (L, D_MODEL)),
        "ffn1_w_gate": normal(ks[3], (L, D_MODEL, D_FF), D_MODEL ** -0.5),
        "ffn1_w_up": normal(ks[4], (L, D_MODEL, D_FF), D_MODEL ** -0.5),
        "ffn1_w_down": normal(ks[5], (L, D_FF, D_MODEL), D_FF ** -0.5),
        "mix_norm_g": gain(ks[6], (L, D_MODEL)),
        "w_in": normal(ks[7], (L, D_MODEL, IN_COLS), D_MODEL ** -0.5),
        "gmlp_v_norm_g": gain(ks[8], (L, GMLP_WIDTH)),
        "gmlp_w_s": normal(ks[9], (L, GMLP_GROUPS, GMLP_CHUNK, GMLP_CHUNK), 0.5 * GMLP_CHUNK ** -0.5),
        "gmlp_b_s": 1.0 + 0.1 * jax.random.normal(ks[10], (L, GMLP_GROUPS, GMLP_CHUNK), f32),
        "mla_q_norm_g": gain(ks[11], (L, Q_LORA_RANK)),
        "mla_w_q_up": normal(ks[12], (L, Q_LORA_RANK, MLA_HEADS * QK_HEAD_DIM), Q_LORA_RANK ** -0.5),
        "mla_kv_norm_g": gain(ks[13], (L, KV_LORA_RANK)),
        "mla_w_kv_up": normal(ks[14], (L, KV_LORA_RANK, MLA_HEADS * (QK_NOPE_DIM + V_HEAD_DIM)), KV_LORA_RANK ** -0.5),
        "mla_q_head_g": gain(ks[15], (L, QK_HEAD_DIM)),
        "mla_k_head_g": gain(ks[16], (L, QK_HEAD_DIM)),
        "gmlp_out_g": gain(ks[17], (L, GMLP_GROUPS, GMLP_GROUP_DIM)),
        "mla_out_g": gain(ks[18], (L, MLA_HEADS, V_HEAD_DIM)),
        "w_out": normal(ks[19], (L, MIX_WIDTH, D_MODEL), MIX_WIDTH ** -0.5),
        "ffn2_norm_g": gain(ks[20], (L, D_MODEL)),
        "ffn2_w_gate": normal(ks[21], (L, D_MODEL, D_FF), D_MODEL ** -0.5),
        "ffn2_w_up": normal(ks[22], (L, D_MODEL, D_FF), D_MODEL ** -0.5),
        "ffn2_w_down": normal(ks[23], (L, D_FF, D_MODEL), D_FF ** -0.5),
    }


def reference(x, positions, ffn1_norm_g, ffn1_w_gate, ffn1_w_up, ffn1_w_down, mix_norm_g, w_in,
              gmlp_v_norm_g, gmlp_w_s, gmlp_b_s, mla_q_norm_g, mla_w_q_up, mla_kv_norm_g,
              mla_w_kv_up, mla_q_head_g, mla_k_head_g, gmlp_out_g, mla_out_g, w_out,
              ffn2_norm_g, ffn2_w_gate, ffn2_w_up, ffn2_w_down):
    B, S, _ = x.shape
    cos, sin = rope_tables(positions)
    split_pts = [2 * GMLP_WIDTH, 2 * GMLP_WIDTH + Q_LORA_RANK,
                 2 * GMLP_WIDTH + Q_LORA_RANK + KV_LORA_RANK]
    for l in range(DEPTH):
        x = x + 0.5 * swiglu(rmsnorm(x, ffn1_norm_g[l]), ffn1_w_gate[l], ffn1_w_up[l], ffn1_w_down[l])
        h = rmsnorm(x, mix_norm_g[l])
        z = h @ w_in[l]
        z_a, c_q, c_kv, k_rope = jnp.split(z, split_pts, axis=-1)
        y_a = gmlp_mixer(z_a, gmlp_v_norm_g[l], gmlp_w_s[l], gmlp_b_s[l])
        y_a = rmsnorm(y_a.reshape(B, S, GMLP_GROUPS, GMLP_GROUP_DIM), gmlp_out_g[l])
        y_b = mla_mixer(c_q, c_kv, k_rope, cos, sin, mla_q_norm_g[l], mla_w_q_up[l],
                        mla_kv_norm_g[l], mla_w_kv_up[l], mla_q_head_g[l], mla_k_head_g[l])
        y_b = rmsnorm(y_b, mla_out_g[l])
        y = jnp.concatenate([y_a.reshape(B, S, GMLP_WIDTH), y_b.reshape(B, S, MLA_HEADS * V_HEAD_DIM)], axis=-1)
        x = x + y @ w_out[l]
        x = x + 0.5 * swiglu(rmsnorm(x, ffn2_norm_g[l]), ffn2_w_gate[l], ffn2_w_up[l], ffn2_w_down[l])
    return x
```

```cpp
#include <hip/hip_runtime.h>
#include <hip/hip_cooperative_groups.h>
#include <cstdio>
#include <cstdint>
namespace cg = cooperative_groups;

#ifndef MK_MULTI
#define MK_MULTI 0
#endif

constexpr int BATCH = 16, SEQ = 2048, DM = 2048, MTOK = BATCH * SEQ, DFF = 5504, NGU = 2 * DFF;
constexpr int ZLD = 3328;
constexpr int NH = 8, QKD = 192, VD = 128, QW = NH * QKD  ;
constexpr float EPS = 1e-6f;

namespace pg8 {
#define PG8_LAS __attribute__((address_space(3)))
typedef unsigned short bf16_t;
typedef short bf16x8 __attribute__((ext_vector_type(8)));
typedef float f32x4 __attribute__((ext_vector_type(4)));
typedef float f32x2 __attribute__((ext_vector_type(2)));
typedef unsigned u32x4 __attribute__((ext_vector_type(4)));
typedef unsigned u32x2 __attribute__((ext_vector_type(2)));
typedef __bf16 bf16x2_t __attribute__((ext_vector_type(2)));
constexpr int BM = 256, BK = 64, HALF = 128, HTB = HALF * BK * 2  , STAGE_BYTES = 8 * HTB, NXCD = 8, WGM = 8;

__host__ __device__ __forceinline__ int lds_byte(int r, int c) { const int st = (r >> 4) * 2 + (c >> 5), rr = r & 15, cc = c & 31, ob = rr * 64 + cc * 2; return st * 1024 + (ob ^ (((ob >> 9) & 1) << 5)); }
__host__ __device__ __forceinline__ void stage_rc(int b, int& R, int& C) { const int st = b / 1024, sb = b % 1024, swz = sb ^ (((sb >> 9) & 1) << 5); R = (st >> 1) * 16 + swz / 64; C = (st & 1) * 32 + (swz % 64) / 2; }
__host__ __device__ __forceinline__ int perm32(int rho) { const int n = rho >> 4, i = rho & 15; return 8 * (i >> 2) + 4 * n + (i & 3); }

struct Unit { int pm, pn; };
struct Gemm { const bf16_t* A; const bf16_t* Bt; int M, N, K, lda, ldb; };

struct StaticOrder {
    int nM, nN, nwg, G, c;
    __host__ __device__ void init(int M, int N, int G_, int c_) { nM = M / BM; nN = N / BM; nwg = nM * nN; G = G_; c = c_; }
    __host__ __device__ bool next(int i, Unit& u) const {
        const long L = (long)i * G + c; if (L >= nwg) return false;
        int wgid = (int)L; { const int q = nwg / NXCD, r = nwg % NXCD, xcd = wgid % NXCD, off = wgid / NXCD; wgid = (xcd < r ? xcd * (q + 1) : r * (q + 1) + (xcd - r) * q) + off; }
        const int nig = WGM * nN, gid = wgid / nig, fm = gid * WGM, gsz = (nM - fm) < WGM ? (nM - fm) : WGM;
        u.pm = fm + ((wgid % nig) % gsz); u.pn = (wgid % nig) / gsz; return true;
    }
};

__device__ __forceinline__ unsigned cvt_pk_bf16(float lo, float hi) { f32x2 v = {lo, hi}; bf16x2_t b = __builtin_convertvector(v, bf16x2_t); return __builtin_bit_cast(unsigned, b); }
__device__ __forceinline__ f32x2 gelu_pk(f32x2 v) {
    const f32x2 av = __builtin_elementwise_abs(v), d = av * 0.2316418882f + 1.0f;
    f32x2 t; t.x = __builtin_amdgcn_rcpf(d.x); t.y = __builtin_amdgcn_rcpf(d.y);
    f32x2 q = t * 0.5307027145f + (-0.7265760135f); q = q * t + 0.7107068705f; q = q * t + (-0.142248368f); q = q * t + 0.127414796f; q = q * t;
    const f32x2 s = (v * v) * (-0.72134752044f);
    f32x2 e; e.x = __builtin_amdgcn_exp2f(s.x); e.y = __builtin_amdgcn_exp2f(s.y);
    const f32x2 m = v * (q * e), r = v - m;
    f32x2 o; o.x = v.x < 0.f ? m.x : r.x; o.y = v.y < 0.f ? m.y : r.y; return o;
}
__device__ __forceinline__ f32x4 gelu4(f32x4 v) { f32x2 a = gelu_pk((f32x2){v[0], v[1]}), b = gelu_pk((f32x2){v[2], v[3]}); return (f32x4){a.x, a.y, b.x, b.y}; }
__device__ __forceinline__ float silu_mul(float g, float u) { return g * u * __builtin_amdgcn_rcpf(1.0f + __builtin_amdgcn_exp2f(-1.4426950408889634f * g)); }

struct Epi {
    int mode; bf16_t* O; int ldc; const float* base; float* out; float alpha; int gelu_tiles;
    __device__ __forceinline__ void operator()(const f32x4 (&acc)[2][2][4][2], const Unit& u, int wr, int wc, int fr, int fq) const {
        const int row0 = u.pm * BM + wr * 64 + fr;
        if (mode == 3) {
            const int col0 = u.pn * BM + wc * 32 + 4 * fq;
#pragma unroll
            for (int ai = 0; ai < 2; ++ai)
#pragma unroll
                for (int m = 0; m < 4; ++m) { const size_t off = (size_t)(row0 + ai * HALF + m * 16) * ldc + col0;
#pragma unroll
                    for (int bj = 0; bj < 2; ++bj)
#pragma unroll
                        for (int n = 0; n < 2; ++n) { const f32x4 bs = *(const f32x4*)(base + off + bj * HALF + n * 16); *(f32x4*)(out + off + bj * HALF + n * 16) = bs + acc[ai][bj][m][n] * alpha; }
                    if (m & 1) asm volatile("" ::: "memory"); }
        } else if (mode == 2) {
            const int col0 = u.pn * HALF + wc * 32 + 8 * fq;
#pragma unroll
            for (int ai = 0; ai < 2; ++ai)
#pragma unroll
                for (int m = 0; m < 4; ++m) { bf16_t* rowp = O + (size_t)(row0 + ai * HALF + m * 16) * ldc + col0;
                    const f32x4 g0 = acc[ai][0][m][0], g1 = acc[ai][0][m][1], u0 = acc[ai][1][m][0], u1 = acc[ai][1][m][1];
                    u32x4 w; w.x = cvt_pk_bf16(silu_mul(g0[0], u0[0]), silu_mul(g0[1], u0[1])); w.y = cvt_pk_bf16(silu_mul(g0[2], u0[2]), silu_mul(g0[3], u0[3]));
                    w.z = cvt_pk_bf16(silu_mul(g1[0], u1[0]), silu_mul(g1[1], u1[1])); w.w = cvt_pk_bf16(silu_mul(g1[2], u1[2]), silu_mul(g1[3], u1[3]));
                    *(u32x4*)rowp = w; }
        } else {
            const int col0 = u.pn * BM + wc * 32 + 8 * fq; const bool act = (mode == 1) && (u.pn < gelu_tiles);
#pragma unroll
            for (int ai = 0; ai < 2; ++ai)
#pragma unroll
                for (int m = 0; m < 4; ++m) { bf16_t* rowp = O + (size_t)(row0 + ai * HALF + m * 16) * ldc + col0;
#pragma unroll
                    for (int bj = 0; bj < 2; ++bj) { f32x4 v0 = acc[ai][bj][m][0], v1 = acc[ai][bj][m][1];
                        if (act) { v0 = gelu4(v0); v1 = gelu4(v1); }
                        u32x4 w; w.x = cvt_pk_bf16(v0[0], v0[1]); w.y = cvt_pk_bf16(v0[2], v0[3]); w.z = cvt_pk_bf16(v1[0], v1[1]); w.w = cvt_pk_bf16(v1[2], v1[3]);
                        *(u32x4*)(rowp + bj * HALF) = w; } }
        }
    }
};

__device__ __forceinline__ void gemm_phase(PG8_LAS unsigned char* lds, const Gemm g, const StaticOrder& S, const Epi& E, const int tid) {
    const int wid = __builtin_amdgcn_readfirstlane(tid >> 6), lane = tid & 63, wr = wid >> 2, wc = wid & 3, fr = lane & 15, fq = lane >> 4;
    const int K = g.K, nt = K / BK; const bool perm = (E.mode != 3);
    unsigned voffA[2], voffB[2];
#pragma unroll
    for (int i = 0; i < 2; ++i) { int R, C; stage_rc(tid * 16 + i * 8192, R, C); const int Rb = perm ? ((R & ~31) + perm32(R & 31)) : R;
        voffA[i] = (unsigned)(R * g.lda + C) * 2u; voffB[i] = (unsigned)(Rb * g.ldb + C) * 2u; }
    const size_t kstep = (size_t)(BK * 2);
    const size_t hstepA = (size_t)HALF * g.lda * 2, hstepB = (size_t)HALF * g.ldb * 2;
    const size_t tstepA = 2 * hstepA, tstepB = 2 * hstepB;
    const unsigned ldsw = (unsigned)wid * 1024u;
    const int aoff = lds_byte(wr * 64 + fr, fq * 8), boff = lds_byte(wc * 32 + fr, fq * 8);
#define PG8_SA(b, h) (((b) * 2 + (h)) * HTB)
#define PG8_SB(b, h) ((4 + (b) * 2 + (h)) * HTB)
#define PG8_STAGE(bufoff, gbase, voff) do { _Pragma("unroll") for (int _i = 0; _i < 2; ++_i) \
        __builtin_amdgcn_global_load_lds((const unsigned*)((const char*)(gbase) + (voff)[_i]), (PG8_LAS unsigned*)(lds + (bufoff) + ldsw + _i * 8192), 16, 0, 0); } while (0)
#define PG8_LDA(dst, b, h) do { _Pragma("unroll") for (int m = 0; m < 4; ++m) _Pragma("unroll") for (int k = 0; k < 2; ++k) dst[m][k] = *(const PG8_LAS bf16x8*)(lds + PG8_SA(b, h) + aoff + m * 2048 + k * 1024); } while (0)
#define PG8_LDB(dst, b, h) do { _Pragma("unroll") for (int n = 0; n < 2; ++n) _Pragma("unroll") for (int k = 0; k < 2; ++k) dst[n][k] = *(const PG8_LAS bf16x8*)(lds + PG8_SB(b, h) + boff + n * 2048 + k * 1024); } while (0)
#define PG8_MMA(ai, bj, At, Bt) do { __builtin_amdgcn_s_setprio(1); _Pragma("unroll") for (int m = 0; m < 4; ++m) _Pragma("unroll") for (int n = 0; n < 2; ++n) _Pragma("unroll") for (int k = 0; k < 2; ++k) \
        acc[ai][bj][m][n] = __builtin_amdgcn_mfma_f32_16x16x32_bf16(Bt[n][k], At[m][k], acc[ai][bj][m][n], 0, 0, 0); __builtin_amdgcn_s_setprio(0); } while (0)
#define PG8_WAIT_V(n) asm volatile("s_waitcnt vmcnt(" #n ")" ::: "memory")
#define PG8_WAIT_L(n) asm volatile("s_waitcnt lgkmcnt(" #n ")" ::: "memory")
#define PG8_BAR __builtin_amdgcn_s_barrier()
#define PG8_SCHED __builtin_amdgcn_sched_barrier(0)
    Unit cur, nxt; int ui = 0;
    if (!S.next(0, cur)) return;
    f32x4 acc[2][2][4][2];
#pragma unroll
    for (int a = 0; a < 2; ++a)
#pragma unroll
        for (int b = 0; b < 2; ++b)
#pragma unroll
            for (int m = 0; m < 4; ++m)
#pragma unroll
                for (int n = 0; n < 2; ++n) acc[a][b][m][n] = (f32x4){0.f, 0.f, 0.f, 0.f};
    bf16x8 At[4][2], B0[2][2], B1[2][2];
    const char* cA = (const char*)g.A + (size_t)cur.pm * tstepA; const char* cB = (const char*)g.Bt + (size_t)cur.pn * tstepB;
    PG8_STAGE(PG8_SB(0, 0), cB, voffB); PG8_STAGE(PG8_SB(0, 1), cB + hstepB, voffB); PG8_STAGE(PG8_SA(0, 0), cA, voffA); PG8_STAGE(PG8_SA(0, 1), cA + hstepA, voffA);
    if (wr == 1) PG8_BAR;
    PG8_WAIT_V(2); PG8_BAR;
    PG8_STAGE(PG8_SB(1, 0), cB + kstep, voffB); PG8_STAGE(PG8_SA(1, 0), cA + kstep, voffA); PG8_STAGE(PG8_SB(1, 1), cB + hstepB + kstep, voffB);
    PG8_WAIT_V(6); PG8_BAR;
    for (;;) {
        const bool has_next = S.next(ui + 1, nxt);
        const char* nA = has_next ? (const char*)g.A + (size_t)nxt.pm * tstepA : cA; const char* nB = has_next ? (const char*)g.Bt + (size_t)nxt.pn * tstepB : cB;
        for (int t = 0; t < nt; t += 2) {
            const bool last = (t == nt - 2);
            const char* a1 = cA + (size_t)(t + 1) * kstep;
            const char* a2 = last ? nA : cA + (size_t)(t + 2) * kstep; const char* b2 = last ? nB : cB + (size_t)(t + 2) * kstep;
            const char* a3 = a2 + kstep; const char* b3 = b2 + kstep;
            PG8_LDB(B0, 0, 0); PG8_LDB(B1, 0, 1); PG8_SCHED; PG8_LDA(At, 0, 0); PG8_STAGE(PG8_SA(1, 1), a1 + hstepA, voffA);
            PG8_WAIT_V(8); PG8_WAIT_L(0); PG8_BAR; PG8_MMA(0, 0, At, B0); PG8_MMA(0, 1, At, B1); PG8_BAR; PG8_SCHED;
            PG8_LDA(At, 0, 1); PG8_STAGE(PG8_SB(0, 0), b2, voffB); PG8_STAGE(PG8_SB(0, 1), b2 + hstepB, voffB); PG8_STAGE(PG8_SA(0, 0), a2, voffA);
            PG8_WAIT_V(8); PG8_WAIT_L(0); PG8_BAR; PG8_MMA(1, 0, At, B0); PG8_MMA(1, 1, At, B1); PG8_BAR; PG8_SCHED;
            PG8_LDB(B0, 1, 0); PG8_LDB(B1, 1, 1); PG8_SCHED; PG8_LDA(At, 1, 0); PG8_STAGE(PG8_SA(0, 1), a2 + hstepA, voffA);
            PG8_WAIT_V(8); PG8_WAIT_L(0); PG8_BAR; PG8_MMA(0, 0, At, B0); PG8_MMA(0, 1, At, B1); PG8_BAR; PG8_SCHED;
            PG8_LDA(At, 1, 1); PG8_STAGE(PG8_SB(1, 0), b3, voffB); PG8_STAGE(PG8_SB(1, 1), b3 + hstepB, voffB); PG8_STAGE(PG8_SA(1, 0), a3, voffA);
            PG8_WAIT_V(8); PG8_WAIT_L(0); PG8_BAR; PG8_MMA(1, 0, At, B0); PG8_MMA(1, 1, At, B1); PG8_BAR; PG8_SCHED;
        }
        if (wr == 0) PG8_BAR;
        E(acc, cur, wr, wc, fr, fq);
        if (!has_next) break;
#pragma unroll
        for (int a = 0; a < 2; ++a)
#pragma unroll
            for (int b = 0; b < 2; ++b)
#pragma unroll
                for (int m = 0; m < 4; ++m)
#pragma unroll
                    for (int n = 0; n < 2; ++n) acc[a][b][m][n] = (f32x4){0.f, 0.f, 0.f, 0.f};
        cur = nxt; cA = nA; cB = nB; ++ui;
        if (wr == 1) PG8_BAR;
    }
    PG8_WAIT_V(0);
    PG8_BAR;
#undef PG8_SA
#undef PG8_SB
#undef PG8_STAGE
#undef PG8_LDA
#undef PG8_LDB
#undef PG8_MMA
#undef PG8_WAIT_V
#undef PG8_WAIT_L
#undef PG8_BAR
#undef PG8_SCHED
}
}

#define LAS __attribute__((address_space(3)))
typedef unsigned short bf16;
typedef float f32x4 __attribute__((ext_vector_type(4)));
typedef float f32x16 __attribute__((ext_vector_type(16)));
typedef short bf16x8 __attribute__((ext_vector_type(8)));
typedef unsigned u32x4 __attribute__((ext_vector_type(4)));
typedef unsigned u32x2 __attribute__((ext_vector_type(2)));
using pg8::cvt_pk_bf16;
__device__ __forceinline__ float bf_lo(unsigned u) { return __uint_as_float(u << 16); }
__device__ __forceinline__ float bf_hi(unsigned u) { return __uint_as_float(u & 0xffff0000u); }
__device__ __forceinline__ float wave_sum(float v) {
#pragma unroll
    for (int o = 1; o < 64; o <<= 1) v += __shfl_xor(v, o);
    return v;
}

constexpr size_t MiB = 1u << 20;
constexpr size_t WS_WGU1 = 2 * MiB, WS_WD1 = 46 * MiB, WS_WGU2 = 68 * MiB, WS_WD2 = 112 * MiB, WS_WIN = 134 * MiB, WS_WQ = 147 * MiB + MiB / 2, WS_WK = 149 * MiB, WS_WV = 150 * MiB, WS_WOUT = 151 * MiB;
constexpr size_t WS_XN = 160 * MiB;
constexpr size_t WS_Y = WS_XN;
constexpr size_t WS_H = 288 * MiB;
constexpr size_t WS_Z = 288 * MiB;
constexpr size_t WS_QRAW = 496 * MiB;
constexpr size_t WS_KRAW = 632 * MiB;
constexpr size_t WS_VT = 696 * MiB;
constexpr size_t WS_Q = 760 * MiB;
constexpr size_t WS_K = 856 * MiB;
constexpr size_t WS_END = 952 * MiB;
static_assert(WS_WGU1 + (size_t)NGU * DM * 2 <= WS_WD1 && WS_WD1 + (size_t)DM * DFF * 2 <= WS_WGU2 && WS_WGU2 + (size_t)NGU * DM * 2 <= WS_WD2 && WS_WD2 + (size_t)DM * DFF * 2 <= WS_WIN, "ws map 1");
static_assert(WS_WIN + (size_t)ZLD * DM * 2 <= WS_WQ && WS_WQ + (size_t)QW * 512 * 2 <= WS_WK && WS_WK + 1024 * 512 * 2 <= WS_WV && WS_WV + 1024 * 512 * 2 <= WS_WOUT && WS_WOUT + (size_t)DM * DM * 2 <= WS_XN, "ws map 2");
static_assert(WS_XN + (size_t)MTOK * DM * 2 <= WS_H && WS_H + (size_t)MTOK * DFF * 2 <= WS_KRAW && WS_Z + (size_t)MTOK * ZLD * 2 <= WS_QRAW && WS_QRAW + (size_t)MTOK * QW * 2 <= WS_KRAW, "ws map 3");
static_assert(WS_KRAW + (size_t)MTOK * 1024 * 2 <= WS_VT && WS_VT + (size_t)MTOK * 1024 * 2 <= WS_Q && WS_Q + (size_t)MTOK * QW * 2 <= WS_K && WS_K + (size_t)MTOK * QW * 2 <= WS_END, "ws map 4");

__device__ __forceinline__ unsigned f2bf(float f) { unsigned u = __builtin_bit_cast(unsigned, f); return (u + 0x7fffu + ((u >> 16) & 1u)) >> 16; }
__device__ __forceinline__ unsigned pk2(float lo, float hi) { return f2bf(lo) | (f2bf(hi) << 16); }
__device__ __forceinline__ void transpose_item(const float* W, int N, bf16* dst  , int K, int k0, int n0, LAS float* scr, int lane) {
#pragma unroll 8
    for (int i = 0; i < 32; ++i) { const int kk = 2 * i + (lane >> 5); scr[kk * 33 + (lane & 31)] = W[(size_t)(k0 + kk) * N + n0 + (lane & 31)]; }
    asm volatile("s_waitcnt lgkmcnt(0)" ::: "memory");
    const int c = lane & 7;
#pragma unroll
    for (int j = 0; j < 4; ++j) { const int n = (lane >> 3) + 8 * j; const LAS float* s = scr + (8 * c) * 33 + n;
        u32x4 o; o.x = pk2(s[0 * 33], s[1 * 33]); o.y = pk2(s[2 * 33], s[3 * 33]); o.z = pk2(s[4 * 33], s[5 * 33]); o.w = pk2(s[6 * 33], s[7 * 33]);
        *(u32x4*)(dst + (size_t)n * K + k0 + 8 * c) = o; }
    asm volatile("s_waitcnt lgkmcnt(0)" ::: "memory");
}
__device__ __forceinline__ void rms_row_to_bf16(const float* xrow, const float* g, bf16* orow, int lane) {
    const f32x4* xr = (const f32x4*)xrow + lane; const f32x4* gr = (const f32x4*)g + lane;
    f32x4 v[8]; float s = 0.f;
#pragma unroll
    for (int j = 0; j < 8; ++j) { v[j] = xr[64 * j]; s += (v[j].x * v[j].x + v[j].y * v[j].y) + (v[j].z * v[j].z + v[j].w * v[j].w); }
    const float r = 1.0f / sqrtf(wave_sum(s) * (1.0f / DM) + EPS);
    u32x2* o8 = (u32x2*)orow + lane;
#pragma unroll
    for (int j = 0; j < 8; ++j) { const f32x4 gg = gr[64 * j]; u32x2 w; w.x = cvt_pk_bf16(v[j].x * r * gg.x, v[j].y * r * gg.y); w.y = cvt_pk_bf16(v[j].z * r * gg.z, v[j].w * r * gg.w); o8[64 * j] = w; }
}

__device__ __forceinline__ void p0_weights(LAS unsigned char* lds, unsigned char* ws, const float* wg1, const float* wu1, const float* wd1, const float* wg2, const float* wu2, const float* wd2,
                                           const float* win, const float* wq, const float* wkv, const float* wout, int gw, int NGW, int wave, int lane) {
    LAS float* scr = (LAS float*)(lds + wave * 8448);
    constexpr int I_F = (DM / 64) * (DFF / 32);
    constexpr int I_IN = (DM / 64) * (3136 / 32), I_Q = (512 / 64) * (QW / 32), I_KV = (512 / 64) * (2048 / 32), I_O = (DM / 64) * (DM / 32);
    constexpr int NITEMS = 6 * I_F + I_IN + I_Q + I_KV + I_O;
    for (int it = gw; it < NITEMS; it += NGW) {
        int r = it;
        if (r < 6 * I_F) {
            const int which = r / I_F; r -= which * I_F; const int ffn = which / 3, kind = which % 3;
            if (kind < 2) { const float* W = wg1; if (which == 1) W = wu1; if (which == 3) W = wg2; if (which == 4) W = wu2; bf16* D = (bf16*)(ws + (ffn ? WS_WGU2 : WS_WGU1));
                const int nblk = DFF / 32, kb = r / nblk, nb = r % nblk, n0 = nb * 32; const int drow = (n0 / 128) * 256 + (n0 % 128) + kind * 128;
                transpose_item(W, DFF, D + (size_t)drow * DM, DM, kb * 64, n0, scr, lane); }
            else { const float* W = wd1; if (ffn) W = wd2; bf16* D = (bf16*)(ws + (ffn ? WS_WD2 : WS_WD1));
                const int nblk = DM / 32, kb = r / nblk, nb = r % nblk, n0 = nb * 32;
                transpose_item(W, DM, D + (size_t)n0 * DFF, DFF, kb * 64, n0, scr, lane); }
            continue;
        }
        r -= 6 * I_F;
        if (r < I_IN) { const int nblk = 3136 / 32, kb = r / nblk, nb = r % nblk, n0 = nb * 32; transpose_item(win, 3136, (bf16*)(ws + WS_WIN) + (size_t)n0 * DM, DM, kb * 64, n0, scr, lane); continue; }
        r -= I_IN;
        if (r < I_Q) { const int nblk = QW / 32, kb = r / nblk, nb = r % nblk, n0 = nb * 32; transpose_item(wq, QW, (bf16*)(ws + WS_WQ) + (size_t)n0 * 512, 512, kb * 64, n0, scr, lane); continue; }
        r -= I_Q;
        if (r < I_KV) { const int nblk = 2048 / 32, kb = r / nblk, nb = r % nblk, n0 = nb * 32; const int h = n0 >> 8, c = n0 & 255;
            bf16* D = (c < 128) ? (bf16*)(ws + WS_WK) + (size_t)(h * 128 + c) * 512 : (bf16*)(ws + WS_WV) + (size_t)(h * 128 + c - 128) * 512;
            transpose_item(wkv, 2048, D, 512, kb * 64, n0, scr, lane); continue; }
        r -= I_KV;
        { const int nblk = DM / 32, kb = r / nblk, nb = r % nblk, n0 = nb * 32; transpose_item(wout, DM, (bf16*)(ws + WS_WOUT) + (size_t)n0 * DM, DM, kb * 64, n0, scr, lane); }
    }
    { u32x4* z = (u32x4*)((bf16*)(ws + WS_WIN) + (size_t)3136 * DM); const int n16 = (ZLD - 3136) * DM * 2 / 16;
      for (int i = gw * 64 + lane; i < n16; i += NGW * 64) z[i] = (u32x4){0u, 0u, 0u, 0u}; }
}

__device__ __forceinline__ void znorm_seg16(bf16* p, const float* g, float invn, int lane, int nvec  ) {
    u32x4 a[2]; float s = 0.f;
#pragma unroll
    for (int j = 0; j < 2; ++j) if (j < nvec) { a[j] = *(const u32x4*)(p + j * 512 + lane * 8);
#pragma unroll
        for (int k = 0; k < 4; ++k) { const float lo = bf_lo(a[j][k]), hi = bf_hi(a[j][k]); s += lo * lo + hi * hi; } }
    const float r = 1.0f / sqrtf(wave_sum(s) * invn + EPS);
#pragma unroll
    for (int j = 0; j < 2; ++j) if (j < nvec) { const f32x4 g0 = *(const f32x4*)(g + j * 512 + lane * 8), g1 = *(const f32x4*)(g + j * 512 + lane * 8 + 4); u32x4 w;
        w.x = cvt_pk_bf16(bf_lo(a[j].x) * r * g0.x, bf_hi(a[j].x) * r * g0.y); w.y = cvt_pk_bf16(bf_lo(a[j].y) * r * g0.z, bf_hi(a[j].y) * r * g0.w);
        w.z = cvt_pk_bf16(bf_lo(a[j].z) * r * g1.x, bf_hi(a[j].z) * r * g1.y); w.w = cvt_pk_bf16(bf_lo(a[j].w) * r * g1.z, bf_hi(a[j].w) * r * g1.w);
        *(u32x4*)(p + j * 512 + lane * 8) = w; }
}

__device__ const double ROPE_REV[32] = {0.15915494309189535, 0.11934937021124886, 0.08949940160889101, 0.06711508300522726, 0.050329212104487035, 0.03774158471741977, 0.0283021958306234, 0.02122365276477766,
    0.015915494309189534, 0.011934937021124886, 0.008949940160889102, 0.006711508300522725, 0.005032921210448704, 0.003774158471741977, 0.00283021958306234, 0.0021223652764777662,
    0.0015915494309189536, 0.0011934937021124885, 0.0008949940160889102, 0.0006711508300522726, 0.0005032921210448703, 0.00037741584717419774, 0.00028302195830623395, 0.0002122365276477766,
    0.00015915494309189535, 0.00011934937021124886, 8.949940160889102e-05, 6.711508300522725e-05, 5.0329212104487035e-05, 3.774158471741978e-05, 2.8302195830623396e-05, 2.122365276477766e-05};
constexpr float QSCALE = 0.07216878364870322f * 1.4426950408889634f;
__device__ __forceinline__ void qk_head(const bf16* nope, const bf16* rope, const float* g, bf16* dst, const float (&cs)[4], const float (&sn)[4], int j, float oscale) {
    const u32x4 a0 = *(const u32x4*)(nope + 16 * j), a1 = *(const u32x4*)(nope + 16 * j + 8);
    const u32x2 r1 = *(const u32x2*)(rope + 4 * j), r2 = *(const u32x2*)(rope + 32 + 4 * j);
    float x[16], y1[4], y2[4];
#pragma unroll
    for (int k = 0; k < 4; ++k) { x[2 * k] = bf_lo(a0[k]); x[2 * k + 1] = bf_hi(a0[k]); x[8 + 2 * k] = bf_lo(a1[k]); x[8 + 2 * k + 1] = bf_hi(a1[k]); }
    y1[0] = bf_lo(r1.x); y1[1] = bf_hi(r1.x); y1[2] = bf_lo(r1.y); y1[3] = bf_hi(r1.y);
    y2[0] = bf_lo(r2.x); y2[1] = bf_hi(r2.x); y2[2] = bf_lo(r2.y); y2[3] = bf_hi(r2.y);
    float s = 0.f;
#pragma unroll
    for (int k = 0; k < 16; ++k) s += x[k] * x[k];
#pragma unroll
    for (int k = 0; k < 4; ++k) s += y1[k] * y1[k] + y2[k] * y2[k];
    s += __shfl_xor(s, 1); s += __shfl_xor(s, 2); s += __shfl_xor(s, 4);
    const float r = 1.0f / sqrtf(s * (1.0f / QKD) + EPS);
    const f32x4 g0 = *(const f32x4*)(g + 16 * j), g1 = *(const f32x4*)(g + 16 * j + 4), g2 = *(const f32x4*)(g + 16 * j + 8), g3 = *(const f32x4*)(g + 16 * j + 12);
    const f32x4 ga = *(const f32x4*)(g + 128 + 4 * j), gb = *(const f32x4*)(g + 160 + 4 * j);
    const float ro = r * oscale;
    u32x4 w0, w1;
    w0.x = cvt_pk_bf16(x[0] * ro * g0.x, x[1] * ro * g0.y); w0.y = cvt_pk_bf16(x[2] * ro * g0.z, x[3] * ro * g0.w); w0.z = cvt_pk_bf16(x[4] * ro * g1.x, x[5] * ro * g1.y); w0.w = cvt_pk_bf16(x[6] * ro * g1.z, x[7] * ro * g1.w);
    w1.x = cvt_pk_bf16(x[8] * ro * g2.x, x[9] * ro * g2.y); w1.y = cvt_pk_bf16(x[10] * ro * g2.z, x[11] * ro * g2.w); w1.z = cvt_pk_bf16(x[12] * ro * g3.x, x[13] * ro * g3.y); w1.w = cvt_pk_bf16(x[14] * ro * g3.z, x[15] * ro * g3.w);
    *(u32x4*)(dst + 16 * j) = w0; *(u32x4*)(dst + 16 * j + 8) = w1;
    float o1[4], o2[4];
#pragma unroll
    for (int k = 0; k < 4; ++k) { const float a = y1[k] * r * ga[k], b = y2[k] * r * gb[k]; o1[k] = (a * cs[k] - b * sn[k]) * oscale; o2[k] = (b * cs[k] + a * sn[k]) * oscale; }
    u32x2 v1, v2; v1.x = cvt_pk_bf16(o1[0], o1[1]); v1.y = cvt_pk_bf16(o1[2], o1[3]); v2.x = cvt_pk_bf16(o2[0], o2[1]); v2.y = cvt_pk_bf16(o2[2], o2[3]);
    *(u32x2*)(dst + 128 + 4 * j) = v1; *(u32x2*)(dst + 160 + 4 * j) = v2;
}
__device__ __forceinline__ void qk_token(int tok, const int* positions, const bf16* Qraw, const bf16* Kraw, const bf16* Z, const float* qg, const float* kg, bf16* Q, bf16* K, int lane) {
    const int h = lane >> 3, j = lane & 7; const int pos = positions[tok];
    float cs[4], sn[4];
#pragma unroll
    for (int k = 0; k < 4; ++k) { const double rev = (double)pos * ROPE_REV[4 * j + k]; const float fr = (float)(rev - __builtin_floor(rev)); cs[k] = __builtin_amdgcn_cosf(fr); sn[k] = __builtin_amdgcn_sinf(fr); }
    qk_head(Qraw + (size_t)tok * QW + h * QKD, Qraw + (size_t)tok * QW + h * QKD + 128, qg, Q + (size_t)tok * QW + h * QKD, cs, sn, j, QSCALE);
    qk_head(Kraw + (size_t)tok * 1024 + h * 128, Z + (size_t)tok * ZLD + 3072, kg, K + (size_t)tok * QW + h * QKD, cs, sn, j, 1.0f);
}

namespace att {
constexpr int KP = 400, VP = 144, KBYTES = 64 * KP, VBYTES = 128 * VP, STAGE = KBYTES + VBYTES;
#define MFMA32(a, b, c) __builtin_amdgcn_mfma_f32_32x32x16_bf16((a), (b), (c), 0, 0, 0)
__device__ __forceinline__ void attn_unit(LAS unsigned char* lds, const bf16* Q, const bf16* K, const bf16* Vt, bf16* Y, const float* gout, int b, int h, int qb, const int tid) {
    const int lane = tid & 63, r32 = lane & 31, hi = lane >> 5; const int wid = __builtin_amdgcn_readfirstlane(tid >> 6);
    const int q0 = qb * 256, qrow = q0 + wid * 32 + r32;
    const size_t tok0 = (size_t)b * SEQ;
    bf16x8 qf[12];
    { const bf16* qp = Q + (tok0 + qrow) * QW + h * QKD + hi * 8;
#pragma unroll
      for (int dk = 0; dk < 12; ++dk) qf[dk] = *(const bf16x8*)(qp + dk * 16); }
    const bf16* ksrc = K + (tok0 + (tid >> 3)) * QW + h * QKD + (tid & 7) * 8;
    const unsigned kdst = (tid >> 3) * KP + (tid & 7) * 16;
    const bf16* vsrc = Vt + (size_t)(h * VD + (tid >> 2)) * MTOK + tok0 + (tid & 3) * 8;
    const unsigned vdst = KBYTES + (tid >> 2) * VP + (tid & 3) * 16;
    const int NT = 4 * (qb + 1), my_last = 4 * qb + (wid >> 1);
    u32x4 kr[3], vr[2];
#pragma unroll
    for (int i = 0; i < 3; ++i) kr[i] = *(const u32x4*)(ksrc + i * 64);
#pragma unroll
    for (int i = 0; i < 2; ++i) vr[i] = *(const u32x4*)(vsrc + i * 32);
    __syncthreads();
#pragma unroll
    for (int i = 0; i < 3; ++i) *(LAS u32x4*)(lds + kdst + i * 128) = kr[i];
#pragma unroll
    for (int i = 0; i < 2; ++i) *(LAS u32x4*)(lds + vdst + i * 64) = vr[i];
    __syncthreads();
    const int pim = (r32 & 16) + ((r32 >> 2) & 1) * 8 + ((r32 >> 3) & 1) * 4 + (r32 & 3);
    const unsigned koff = pim * KP + hi * 16, voff = KBYTES + r32 * VP + hi * 16;
    f32x16 o[4];
#pragma unroll
    for (int d = 0; d < 4; ++d)
#pragma unroll
        for (int r = 0; r < 16; ++r) o[d][r] = 0.f;
    float m_run = -1e30f, l_run = 0.f;
    for (int t = 0; t < NT; ++t) {
        const unsigned bo = (t & 1) * STAGE;
        const bool more = (t + 1 < NT);
        if (more) {
#pragma unroll
            for (int i = 0; i < 3; ++i) kr[i] = *(const u32x4*)(ksrc + (size_t)(t + 1) * 64 * QW + i * 64);
#pragma unroll
            for (int i = 0; i < 2; ++i) vr[i] = *(const u32x4*)(vsrc + (t + 1) * 64 + i * 32);
        }
        if (t <= my_last) {
            f32x16 s0, s1;
#pragma unroll
            for (int r = 0; r < 16; ++r) { s0[r] = 0.f; s1[r] = 0.f; }
#pragma unroll
            for (int dk = 0; dk < 12; ++dk) {
                const bf16x8 k0 = *(const LAS bf16x8*)(lds + bo + koff + dk * 32), k1 = *(const LAS bf16x8*)(lds + bo + koff + 32 * KP + dk * 32);
                s0 = MFMA32(k0, qf[dk], s0); s1 = MFMA32(k1, qf[dk], s1);
            }
            if (t >= 4 * qb) {
                const int kb0 = 64 * t + 8 * hi;
#pragma unroll
                for (int r = 0; r < 16; ++r) { const int key = kb0 + 16 * (r >> 3) + (r & 7); if (key > qrow) s0[r] = -1e30f; if (key + 32 > qrow) s1[r] = -1e30f; }
            }
            float mx = s0[0];
#pragma unroll
            for (int r = 1; r < 16; ++r) mx = fmaxf(mx, s0[r]);
#pragma unroll
            for (int r = 0; r < 16; ++r) mx = fmaxf(mx, s1[r]);
            mx = fmaxf(mx, __shfl_xor(mx, 32));
            const float m_new = fmaxf(m_run, mx), alpha = __builtin_amdgcn_exp2f(m_run - m_new);
            m_run = m_new;
            float ls = 0.f;
#pragma unroll
            for (int r = 0; r < 16; ++r) { s0[r] = __builtin_amdgcn_exp2f(s0[r] - m_new); s1[r] = __builtin_amdgcn_exp2f(s1[r] - m_new); ls += s0[r] + s1[r]; }
            l_run = l_run * alpha + ls;
#pragma unroll
            for (int d = 0; d < 4; ++d)
#pragma unroll
                for (int r = 0; r < 16; ++r) o[d][r] *= alpha;
            u32x4 pw[4];
#pragma unroll
            for (int c = 0; c < 2; ++c) {
                pw[c] = (u32x4){cvt_pk_bf16(s0[8 * c], s0[8 * c + 1]), cvt_pk_bf16(s0[8 * c + 2], s0[8 * c + 3]), cvt_pk_bf16(s0[8 * c + 4], s0[8 * c + 5]), cvt_pk_bf16(s0[8 * c + 6], s0[8 * c + 7])};
                pw[2 + c] = (u32x4){cvt_pk_bf16(s1[8 * c], s1[8 * c + 1]), cvt_pk_bf16(s1[8 * c + 2], s1[8 * c + 3]), cvt_pk_bf16(s1[8 * c + 4], s1[8 * c + 5]), cvt_pk_bf16(s1[8 * c + 6], s1[8 * c + 7])};
            }
#pragma unroll
            for (int kc = 0; kc < 4; ++kc) {
                const bf16x8 pf = __builtin_bit_cast(bf16x8, pw[kc]);
#pragma unroll
                for (int d = 0; d < 4; ++d) { const bf16x8 vf = *(const LAS bf16x8*)(lds + bo + voff + d * 32 * VP + kc * 32); o[d] = MFMA32(vf, pf, o[d]); }
            }
        }
        if (more) {
            const unsigned nb = ((t + 1) & 1) * STAGE;
#pragma unroll
            for (int i = 0; i < 3; ++i) *(LAS u32x4*)(lds + nb + kdst + i * 128) = kr[i];
#pragma unroll
            for (int i = 0; i < 2; ++i) *(LAS u32x4*)(lds + nb + vdst + i * 64) = vr[i];
        }
        __syncthreads();
    }
    const float l = l_run + __shfl_xor(l_run, 32), inv = 1.0f / l;
    float ss = 0.f;
#pragma unroll
    for (int d = 0; d < 4; ++d)
#pragma unroll
        for (int r = 0; r < 16; ++r) { o[d][r] *= inv; ss += o[d][r] * o[d][r]; }
    ss += __shfl_xor(ss, 32);
    const float rn = 1.0f / sqrtf(ss * (1.0f / VD) + EPS);
    bf16* yp = Y + (tok0 + qrow) * DM + 1024 + h * VD + 4 * hi; const float* gp = gout + h * VD + 4 * hi;
#pragma unroll
    for (int d = 0; d < 4; ++d)
#pragma unroll
        for (int r4 = 0; r4 < 4; ++r4) { const f32x4 g = *(const f32x4*)(gp + 32 * d + 8 * r4); u32x2 w;
            w.x = cvt_pk_bf16(o[d][4 * r4] * rn * g.x, o[d][4 * r4 + 1] * rn * g.y); w.y = cvt_pk_bf16(o[d][4 * r4 + 2] * rn * g.z, o[d][4 * r4 + 3] * rn * g.w);
            *(u32x2*)(yp + 32 * d + 8 * r4) = w; }
}
}

namespace gm {
constexpr int WP = 272;
constexpr int WBYTES = 128 * WP;
__device__ __forceinline__ void gmlp_phase(LAS unsigned char* lds, const bf16* Z, const float* w_s, const float* b_s, const float* gout, bf16* Y, int vcu, int G, const int tid) {
    const int lane = tid & 63, l16 = lane & 15, q4 = lane >> 4; const int wid = __builtin_amdgcn_readfirstlane(tid >> 6);
    int gcur = -1;
    for (int un = vcu; un < 2048; un += G) {
        const int g = un & 7, bc = un >> 3;
        const size_t tok0 = (size_t)bc * 128;
        __syncthreads();
        if (g != gcur) {
            gcur = g;
#pragma unroll
            for (int i = 0; i < 8; ++i) { const int p = tid + 512 * i, t = p >> 5, s = (p & 31) * 4; const f32x4 w = *(const f32x4*)(w_s + (size_t)g * 16384 + t * 128 + s);
                u32x2 o; o.x = cvt_pk_bf16(s <= t ? w.x : 0.f, s + 1 <= t ? w.y : 0.f); o.y = cvt_pk_bf16(s + 2 <= t ? w.z : 0.f, s + 3 <= t ? w.w : 0.f);
                *(LAS u32x2*)(lds + t * WP + s * 2) = o; }
        }
#pragma unroll
        for (int i = 0; i < 4; ++i) { const int p = tid + 512 * i, s = p >> 4, seg = p & 15; const u32x4 v = *(const u32x4*)(Z + (tok0 + s) * ZLD + 1024 + g * 128 + seg * 8);
            LAS unsigned short* dst = (LAS unsigned short*)(lds + WBYTES + (seg * 8) * WP + s * 2);
#pragma unroll
            for (int k = 0; k < 4; ++k) { dst[(2 * k) * (WP / 2)] = (unsigned short)(v[k] & 0xffffu); dst[(2 * k + 1) * (WP / 2)] = (unsigned short)(v[k] >> 16); } }
        __syncthreads();
        pg8::f32x4 acc[8];
#pragma unroll
        for (int d = 0; d < 8; ++d) acc[d] = (pg8::f32x4){0.f, 0.f, 0.f, 0.f};
        const int nsb = (wid >> 1) + 1;
        for (int sb = 0; sb < nsb; ++sb) {
            const bf16x8 wf = *(const LAS bf16x8*)(lds + (16 * wid + l16) * WP + sb * 64 + q4 * 16);
#pragma unroll
            for (int d = 0; d < 8; ++d) { const bf16x8 vf = *(const LAS bf16x8*)(lds + WBYTES + (16 * d + l16) * WP + sb * 64 + q4 * 16); acc[d] = __builtin_amdgcn_mfma_f32_16x16x32_bf16(vf, wf, acc[d], 0, 0, 0); }
        }
        const int t = 16 * wid + l16; const float bs = b_s[g * 128 + t];
        const bf16* up = Z + (tok0 + t) * ZLD + g * 128 + 4 * q4;
        float ss = 0.f;
#pragma unroll
        for (int d = 0; d < 8; ++d) { const u32x2 uu = *(const u32x2*)(up + 16 * d);
            acc[d][0] = bf_lo(uu.x) * (acc[d][0] + bs); acc[d][1] = bf_hi(uu.x) * (acc[d][1] + bs); acc[d][2] = bf_lo(uu.y) * (acc[d][2] + bs); acc[d][3] = bf_hi(uu.y) * (acc[d][3] + bs);
            ss += (acc[d][0] * acc[d][0] + acc[d][1] * acc[d][1]) + (acc[d][2] * acc[d][2] + acc[d][3] * acc[d][3]); }
        ss += __shfl_xor(ss, 16); ss += __shfl_xor(ss, 32);
        const float rn = 1.0f / sqrtf(ss * (1.0f / 128.0f) + EPS);
        bf16* yp = Y + (tok0 + t) * DM + g * 128 + 4 * q4; const float* gp = gout + g * 128 + 4 * q4;
#pragma unroll
        for (int d = 0; d < 8; ++d) { const f32x4 gg = *(const f32x4*)(gp + 16 * d); u32x2 w; w.x = cvt_pk_bf16(acc[d][0] * rn * gg.x, acc[d][1] * rn * gg.y); w.y = cvt_pk_bf16(acc[d][2] * rn * gg.z, acc[d][3] * rn * gg.w);
            *(u32x2*)(yp + 16 * d) = w; }
    }
}
}

constexpr int LDS_BYTES = 147456;
constexpr int NPHASE = 13;
struct Args { const float* in[24]; float* out; unsigned char* ws; int ph_lo, ph_hi; };

__global__ void __launch_bounds__(512, 2) fwd_megakernel(Args a) {
    extern __shared__ __attribute__((aligned(16))) unsigned char lds_raw[];
    LAS unsigned char* lds = (LAS unsigned char*)lds_raw;
    cg::grid_group grid = cg::this_grid();
    const int G = gridDim.x, bx = blockIdx.x; const int vcu = (G % 8 == 0) ? (bx % 8) * (G / 8) + bx / 8 : bx;
    const int NGW = G * 8;
    for (int ph = a.ph_lo; ph < a.ph_hi; ++ph) {
    int tid = threadIdx.x; asm volatile("" : "+v"(tid));
    unsigned char* ws = a.ws; asm volatile("" : "+s"(ws)); float* out = a.out; asm volatile("" : "+s"(out));
    const int lane = tid & 63, wave = __builtin_amdgcn_readfirstlane(tid >> 6), gw = vcu * 8 + wave;
    bf16* XN = (bf16*)(ws + WS_XN); bf16* Yb = (bf16*)(ws + WS_Y); bf16* H = (bf16*)(ws + WS_H); bf16* Z = (bf16*)(ws + WS_Z);
    bf16* QRAW = (bf16*)(ws + WS_QRAW); bf16* KRAW = (bf16*)(ws + WS_KRAW); bf16* VT = (bf16*)(ws + WS_VT); bf16* Qb = (bf16*)(ws + WS_Q); bf16* Kb = (bf16*)(ws + WS_K);
        const bool is_gemm = (ph == 1 || ph == 2 || ph == 4 || ph == 6 || ph == 9 || ph == 11 || ph == 12);
        if (is_gemm) {
            const int nsub = (ph == 6) ? 3 : 1;
            for (int sub = 0; sub < nsub; ++sub) {
                pg8::Gemm g; pg8::Epi E; E.mode = 0; E.O = nullptr; E.ldc = 0; E.base = nullptr; E.out = nullptr; E.alpha = 0.f; E.gelu_tiles = 0;
                if (ph == 1 || ph == 11) { g = pg8::Gemm{XN, (const bf16*)(ws + (ph == 1 ? WS_WGU1 : WS_WGU2)), MTOK, NGU, DM, DM, DM}; E.mode = 2; E.O = H; E.ldc = DFF; }
                else if (ph == 2 || ph == 12) { g = pg8::Gemm{H, (const bf16*)(ws + (ph == 2 ? WS_WD1 : WS_WD2)), MTOK, DM, DFF, DFF, DFF}; E.mode = 3; E.base = (ph == 2) ? a.in[0] : out; E.out = out; E.ldc = DM; E.alpha = 0.5f; }
                else if (ph == 4) { g = pg8::Gemm{XN, (const bf16*)(ws + WS_WIN), MTOK, ZLD, DM, DM, DM}; E.mode = 1; E.O = Z; E.ldc = ZLD; E.gelu_tiles = 8; }
                else if (ph == 9) { g = pg8::Gemm{Yb, (const bf16*)(ws + WS_WOUT), MTOK, DM, DM, DM, DM}; E.mode = 3; E.base = out; E.out = out; E.ldc = DM; E.alpha = 1.0f; }
                else if (sub == 0) { g = pg8::Gemm{Z + 2048, (const bf16*)(ws + WS_WQ), MTOK, QW, 512, ZLD, 512}; E.O = QRAW; E.ldc = QW; }
                else if (sub == 1) { g = pg8::Gemm{Z + 2560, (const bf16*)(ws + WS_WK), MTOK, 1024, 512, ZLD, 512}; E.O = KRAW; E.ldc = 1024; }
                else { g = pg8::Gemm{(const bf16*)(ws + WS_WV), Z + 2560, 1024, MTOK, 512, 512, ZLD}; E.O = VT; E.ldc = MTOK; }
                pg8::StaticOrder S; S.init(g.M, g.N, G, bx);
#ifndef NO_GEMM
                pg8::gemm_phase(lds, g, S, E, tid);
#endif
            }
#ifndef NO_GM
            if (ph == 6) gm::gmlp_phase(lds, Z, a.in[9], a.in[10], a.in[17], Yb, vcu, G, tid);
#endif
        } else if (ph == 0) {
            p0_weights(lds, ws, a.in[3], a.in[4], a.in[5], a.in[21], a.in[22], a.in[23], a.in[7], a.in[12], a.in[14], a.in[19], gw, NGW, wave, lane);
            for (int m = gw; m < MTOK; m += NGW) rms_row_to_bf16(a.in[0] + (size_t)m * DM, a.in[2], XN + (size_t)m * DM, lane);
        } else if (ph == 3 || ph == 10) {
            const float* gsel = (ph == 3) ? a.in[6] : a.in[20];
            for (int m = gw; m < MTOK; m += NGW) rms_row_to_bf16(out + (size_t)m * DM, gsel, XN + (size_t)m * DM, lane);
        } else if (ph == 5) {
            for (int m = gw; m < MTOK; m += NGW) { bf16* zr = Z + (size_t)m * ZLD;
                znorm_seg16(zr + 1024, a.in[8], 1.0f / 1024.0f, lane, 2); znorm_seg16(zr + 2048, a.in[11], 1.0f / 512.0f, lane, 1); znorm_seg16(zr + 2560, a.in[13], 1.0f / 512.0f, lane, 1); }
        } else if (ph == 7) {
            for (int m = gw; m < MTOK; m += NGW) qk_token(m, (const int*)a.in[1], QRAW, KRAW, Z, a.in[15], a.in[16], Qb, Kb, lane);
        } else if (ph == 8) {
            for (int v = vcu; v < 256; v += G) { const int bh = v >> 1, s0 = (v & 1) * 2;
#pragma unroll 1
                for (int i = 0; i < 4; ++i) { const int qb = (i == 0) ? 7 - s0 : (i == 1) ? s0 : (i == 2) ? 6 - s0 : s0 + 1;
#ifndef NO_ATT
                    att::attn_unit(lds, Qb, Kb, VT, Yb, a.in[18], bh >> 3, bh & 7, qb, tid);
#endif
                } }
        }
        if (ph + 1 < a.ph_hi) grid.sync();
    }
}

extern "C" void kernel_launch(void* const* d_in, const int* in_sizes, int n_in, void* d_out, int out_size, void* d_ws, size_t ws_size, hipStream_t stream) {
    static int grid = 0;
    if (grid == 0) {
        if (n_in != 24 || out_size != MTOK * DM || ws_size < WS_END) { fprintf(stderr, "kernel_launch: unexpected problem (n_in %d, out %d, ws %zu); nothing launched\n", n_in, out_size, ws_size); grid = -1; return; }
        int dev = 0, cus = 0, per_cu = 0;
        if (hipGetDevice(&dev) != hipSuccess || hipDeviceGetAttribute(&cus, hipDeviceAttributeMultiprocessorCount, dev) != hipSuccess) { grid = -1; return; }
        if (hipFuncSetAttribute((const void*)fwd_megakernel, hipFuncAttributeMaxDynamicSharedMemorySize, LDS_BYTES) != hipSuccess) { fprintf(stderr, "kernel_launch: hipFuncSetAttribute failed\n"); grid = -1; return; }
        if (hipOccupancyMaxActiveBlocksPerMultiprocessor(&per_cu, (const void*)fwd_megakernel, 512, LDS_BYTES) != hipSuccess || per_cu < 1) { fprintf(stderr, "kernel_launch: occupancy query says %d\n", per_cu); per_cu = 1; }
        (void)hipGetLastError();
        grid = cus * per_cu;
        if (grid % 8 != 0 || grid > 2048) grid = cus;
    }
    if (grid < 0) return;
    Args a{};
    for (int i = 0; i < 24; ++i) a.in[i] = (const float*)d_in[i];
    a.out = (float*)d_out; a.ws = (unsigned char*)d_ws;
#if MK_MULTI
    for (int ph = 0; ph < NPHASE; ++ph) { a.ph_lo = ph; a.ph_hi = ph + 1; hipLaunchKernelGGL(fwd_megakernel, dim3(grid), dim3(512), LDS_BYTES, stream, a); }
#else
    a.ph_lo = 0; a.ph_hi = NPHASE;
    void* args[] = {&a};
    hipError_t e = hipLaunchCooperativeKernel((const void*)fwd_megakernel, dim3(grid), dim3(512), args, LDS_BYTES, stream);
    if (e != hipSuccess) fprintf(stderr, "kernel_launch: cooperative launch failed: %s (grid %d)\n", hipGetErrorString(e), grid);
#endif
}
```

```cpp
#include <hip/hip_runtime.h>
#include <hip/hip_cooperative_groups.h>
#include <cstdio>
#include <cstdint>
namespace cg = cooperative_groups;

#ifndef MK_MULTI
#define MK_MULTI 0
#endif

constexpr int BATCH = 16, SEQ = 2048, DM = 2048, MTOK = BATCH * SEQ, DFF = 5504, NGU = 2 * DFF;
constexpr int ZLD = 3328;
constexpr int NH = 8, QKD = 192, VD = 128, QW = NH * QKD  ;
constexpr float EPS = 1e-6f;

namespace pg8 {
#define PG8_LAS __attribute__((address_space(3)))
typedef unsigned short bf16_t;
typedef short bf16x8 __attribute__((ext_vector_type(8)));
typedef float f32x4 __attribute__((ext_vector_type(4)));
typedef float f32x2 __attribute__((ext_vector_type(2)));
typedef unsigned u32x4 __attribute__((ext_vector_type(4)));
typedef unsigned u32x2 __attribute__((ext_vector_type(2)));
typedef __bf16 bf16x2_t __attribute__((ext_vector_type(2)));
constexpr int BM = 256, BK = 64, HALF = 128, HTB = HALF * BK * 2  , STAGE_BYTES = 8 * HTB, NXCD = 8, WGM = 8;

__host__ __device__ __forceinline__ int lds_byte(int r, int c) { const int st = (r >> 4) * 2 + (c >> 5), rr = r & 15, cc = c & 31, ob = rr * 64 + cc * 2; return st * 1024 + (ob ^ (((ob >> 9) & 1) << 5)); }
__host__ __device__ __forceinline__ void stage_rc(int b, int& R, int& C) { const int st = b / 1024, sb = b % 1024, swz = sb ^ (((sb >> 9) & 1) << 5); R = (st >> 1) * 16 + swz / 64; C = (st & 1) * 32 + (swz % 64) / 2; }
__host__ __device__ __forceinline__ int perm32(int rho) { const int n = rho >> 4, i = rho & 15; return 8 * (i >> 2) + 4 * n + (i & 3); }

struct Unit { int pm, pn; };
struct Gemm { const bf16_t* A; const bf16_t* Bt; int M, N, K, lda, ldb; };

struct StaticOrder {
    int nM, nN, nwg, G, c;
    __host__ __device__ void init(int M, int N, int G_, int c_) { nM = M / BM; nN = N / BM; nwg = nM * nN; G = G_; c = c_; }
    __host__ __device__ bool next(int i, Unit& u) const {
        const long L = (long)i * G + c; if (L >= nwg) return false;
        int wgid = (int)L; { const int q = nwg / NXCD, r = nwg % NXCD, xcd = wgid % NXCD, off = wgid / NXCD; wgid = (xcd < r ? xcd * (q + 1) : r * (q + 1) + (xcd - r) * q) + off; }
        const int nig = WGM * nN, gid = wgid / nig, fm = gid * WGM, gsz = (nM - fm) < WGM ? (nM - fm) : WGM;
        u.pm = fm + ((wgid % nig) % gsz); u.pn = (wgid % nig) / gsz; return true;
    }
};

__device__ __forceinline__ unsigned cvt_pk_bf16(float lo, float hi) { f32x2 v = {lo, hi}; bf16x2_t b = __builtin_convertvector(v, bf16x2_t); return __builtin_bit_cast(unsigned, b); }
__device__ __forceinline__ f32x2 gelu_pk(f32x2 v) {
    const f32x2 av = __builtin_elementwise_abs(v), d = av * 0.2316418882f + 1.0f;
    f32x2 t; t.x = __builtin_amdgcn_rcpf(d.x); t.y = __builtin_amdgcn_rcpf(d.y);
    f32x2 q = t * 0.5307027145f + (-0.7265760135f); q = q * t + 0.7107068705f; q = q * t + (-0.142248368f); q = q * t + 0.127414796f; q = q * t;
    const f32x2 s = (v * v) * (-0.72134752044f);
    f32x2 e; e.x = __builtin_amdgcn_exp2f(s.x); e.y = __builtin_amdgcn_exp2f(s.y);
    const f32x2 m = v * (q * e), r = v - m;
    f32x2 o; o.x = v.x < 0.f ? m.x : r.x; o.y = v.y < 0.f ? m.y : r.y; return o;
}
__device__ __forceinline__ f32x4 gelu4(f32x4 v) { f32x2 a = gelu_pk((f32x2){v[0], v[1]}), b = gelu_pk((f32x2){v[2], v[3]}); return (f32x4){a.x, a.y, b.x, b.y}; }
__device__ __forceinline__ float silu_mul(float g, float u) { return g * u * __builtin_amdgcn_rcpf(1.0f + __builtin_amdgcn_exp2f(-1.4426950408889634f * g)); }

struct Epi {
    int mode; bf16_t* O; int ldc; const float* base; float* out; float alpha; const float* rs; float rs_invn; bf16_t* xb; float* ss_out;
    __device__ __forceinline__ void operator()(const f32x4 (&acc)[2][2][4][2], const Unit& u, int wr, int wc, int fr, int fq) const {
        const int row0 = u.pm * BM + wr * 64 + fr;
#ifdef FORCE_MODE
        const int mode = FORCE_MODE;
#endif
        if (mode == 3) {
            const int col0 = u.pn * BM + wc * 32 + 4 * fq;
#pragma unroll
            for (int ai = 0; ai < 2; ++ai)
#pragma unroll
                for (int m = 0; m < 4; ++m) { const int row = row0 + ai * HALF + m * 16; const size_t off = (size_t)row * ldc + col0; float ssr = 0.f;
#pragma unroll
                    for (int bj = 0; bj < 2; ++bj)
#pragma unroll
                        for (int n = 0; n < 2; ++n) { const f32x4 bs = *(const f32x4*)(base + off + bj * HALF + n * 16); const f32x4 o = bs + acc[ai][bj][m][n] * alpha; *(f32x4*)(out + off + bj * HALF + n * 16) = o;
                            if (xb) { ssr += (o[0] * o[0] + o[1] * o[1]) + (o[2] * o[2] + o[3] * o[3]); u32x2 w; w.x = cvt_pk_bf16(o[0], o[1]); w.y = cvt_pk_bf16(o[2], o[3]); *(u32x2*)(xb + off + bj * HALF + n * 16) = w; } }
                    if (xb) { ssr += __shfl_xor(ssr, 16); ssr += __shfl_xor(ssr, 32); if (fq == 0) atomicAdd(ss_out + row, ssr); }
                    if (m & 1) asm volatile("" ::: "memory"); }
            return;
        }
        f32x4 cs[2][2];
#pragma unroll
        for (int bj = 0; bj < 2; ++bj)
#pragma unroll
            for (int n = 0; n < 2; ++n) cs[bj][n] = (f32x4){1.f, 1.f, 1.f, 1.f};
        if (mode == 4) {
            const int c0 = u.pn * BM + wc * 32 + 8 * fq;
#pragma unroll
            for (int bj = 0; bj < 2; ++bj)
#pragma unroll
                for (int n = 0; n < 2; ++n) { const f32x4 s = *(const f32x4*)(rs + c0 + bj * HALF + 4 * n);
#pragma unroll
                    for (int i = 0; i < 4; ++i) cs[bj][n][i] = __builtin_amdgcn_rsqf(s[i] * rs_invn + 1e-6f); }
        }
        const bool rowscale = (rs != nullptr) && (mode != 4);
        const bool act = (mode == 1) && (u.pn < 8), stat = (mode == 1) && (u.pn >= 4) && (u.pn < 12);
        float* ssp = ss_out + (u.pn < 8 ? 0 : (u.pn < 10 ? 32768 : 65536));
        const int col0 = (mode == 2 ? u.pn * HALF : u.pn * BM) + wc * 32 + 8 * fq;
#pragma unroll
        for (int ai = 0; ai < 2; ++ai)
#pragma unroll
            for (int m = 0; m < 4; ++m) { const int row = row0 + ai * HALF + m * 16; bf16_t* rowp = O + (size_t)row * ldc + col0;
                float r = 1.0f; if (rowscale) r = __builtin_amdgcn_rsqf(rs[row] * rs_invn + 1e-6f);
                if (mode == 2) {
                    const f32x4 g0 = acc[ai][0][m][0] * r, g1 = acc[ai][0][m][1] * r, u0 = acc[ai][1][m][0] * r, u1 = acc[ai][1][m][1] * r;
                    u32x4 w; w.x = cvt_pk_bf16(silu_mul(g0[0], u0[0]), silu_mul(g0[1], u0[1])); w.y = cvt_pk_bf16(silu_mul(g0[2], u0[2]), silu_mul(g0[3], u0[3]));
                    w.z = cvt_pk_bf16(silu_mul(g1[0], u1[0]), silu_mul(g1[1], u1[1])); w.w = cvt_pk_bf16(silu_mul(g1[2], u1[2]), silu_mul(g1[3], u1[3]));
                    *(u32x4*)rowp = w;
                } else {
                    float ssr = 0.f;
#pragma unroll
                    for (int bj = 0; bj < 2; ++bj) { f32x4 v0 = acc[ai][bj][m][0] * cs[bj][0] * r, v1 = acc[ai][bj][m][1] * cs[bj][1] * r;
                        if (act) { v0 = gelu4(v0); v1 = gelu4(v1); }
                        ssr += (v0[0] * v0[0] + v0[1] * v0[1]) + (v0[2] * v0[2] + v0[3] * v0[3]) + (v1[0] * v1[0] + v1[1] * v1[1]) + (v1[2] * v1[2] + v1[3] * v1[3]);
                        u32x4 w; w.x = cvt_pk_bf16(v0[0], v0[1]); w.y = cvt_pk_bf16(v0[2], v0[3]); w.z = cvt_pk_bf16(v1[0], v1[1]); w.w = cvt_pk_bf16(v1[2], v1[3]);
                        *(u32x4*)(rowp + bj * HALF) = w; }
                    if (stat) { ssr += __shfl_xor(ssr, 16); ssr += __shfl_xor(ssr, 32); if (fq == 0) atomicAdd(ssp + row, ssr); }
                }
            }
    }
};

__device__ __forceinline__ void gemm_phase(PG8_LAS unsigned char* lds, const Gemm g, const StaticOrder& S, const Epi& E, const int tid) {
    const int wid = __builtin_amdgcn_readfirstlane(tid >> 6), lane = tid & 63, wr = wid >> 2, wc = wid & 3, fr = lane & 15, fq = lane >> 4;
    const int K = g.K, nt = K / BK; const bool perm = (E.mode != 3);
    unsigned voffA[2], voffB[2];
#pragma unroll
    for (int i = 0; i < 2; ++i) { int R, C; stage_rc(tid * 16 + i * 8192, R, C); const int Rb = perm ? ((R & ~31) + perm32(R & 31)) : R;
        voffA[i] = (unsigned)(R * g.lda + C) * 2u; voffB[i] = (unsigned)(Rb * g.ldb + C) * 2u; }
    const size_t kstep = (size_t)(BK * 2);
    const size_t hstepA = (size_t)HALF * g.lda * 2, hstepB = (size_t)HALF * g.ldb * 2;
    const size_t tstepA = 2 * hstepA, tstepB = 2 * hstepB;
    const unsigned ldsw = (unsigned)wid * 1024u;
    const int aoff = lds_byte(wr * 64 + fr, fq * 8), boff = lds_byte(wc * 32 + fr, fq * 8);
#define PG8_SA(b, h) (((b) * 2 + (h)) * HTB)
#define PG8_SB(b, h) ((4 + (b) * 2 + (h)) * HTB)
#define PG8_STAGE(bufoff, gbase, voff) do { _Pragma("unroll") for (int _i = 0; _i < 2; ++_i) \
        __builtin_amdgcn_global_load_lds((const unsigned*)((const char*)(gbase) + (voff)[_i]), (PG8_LAS unsigned*)(lds + (bufoff) + ldsw + _i * 8192), 16, 0, 0); } while (0)
#define PG8_LDA(dst, b, h) do { _Pragma("unroll") for (int m = 0; m < 4; ++m) _Pragma("unroll") for (int k = 0; k < 2; ++k) dst[m][k] = *(const PG8_LAS bf16x8*)(lds + PG8_SA(b, h) + aoff + m * 2048 + k * 1024); } while (0)
#define PG8_LDB(dst, b, h) do { _Pragma("unroll") for (int n = 0; n < 2; ++n) _Pragma("unroll") for (int k = 0; k < 2; ++k) dst[n][k] = *(const PG8_LAS bf16x8*)(lds + PG8_SB(b, h) + boff + n * 2048 + k * 1024); } while (0)
#define PG8_MMA(ai, bj, At, Bt) do { __builtin_amdgcn_s_setprio(1); _Pragma("unroll") for (int m = 0; m < 4; ++m) _Pragma("unroll") for (int n = 0; n < 2; ++n) _Pragma("unroll") for (int k = 0; k < 2; ++k) \
        acc[ai][bj][m][n] = __builtin_amdgcn_mfma_f32_16x16x32_bf16(Bt[n][k], At[m][k], acc[ai][bj][m][n], 0, 0, 0); __builtin_amdgcn_s_setprio(0); } while (0)
#define PG8_WAIT_V(n) asm volatile("s_waitcnt vmcnt(" #n ")" ::: "memory")
#define PG8_WAIT_L(n) asm volatile("s_waitcnt lgkmcnt(" #n ")" ::: "memory")
#define PG8_BAR __builtin_amdgcn_s_barrier()
#define PG8_SCHED __builtin_amdgcn_sched_barrier(0)
    Unit cur, nxt; int ui = 0;
    if (!S.next(0, cur)) return;
    f32x4 acc[2][2][4][2];
#pragma unroll
    for (int a = 0; a < 2; ++a)
#pragma unroll
        for (int b = 0; b < 2; ++b)
#pragma unroll
            for (int m = 0; m < 4; ++m)
#pragma unroll
                for (int n = 0; n < 2; ++n) acc[a][b][m][n] = (f32x4){0.f, 0.f, 0.f, 0.f};
    bf16x8 At[4][2], B0[2][2], B1[2][2];
    const char* cA = (const char*)g.A + (size_t)cur.pm * tstepA; const char* cB = (const char*)g.Bt + (size_t)cur.pn * tstepB;
    PG8_STAGE(PG8_SB(0, 0), cB, voffB); PG8_STAGE(PG8_SB(0, 1), cB + hstepB, voffB); PG8_STAGE(PG8_SA(0, 0), cA, voffA); PG8_STAGE(PG8_SA(0, 1), cA + hstepA, voffA);
    if (wr == 1) PG8_BAR;
    PG8_WAIT_V(2); PG8_BAR;
    PG8_STAGE(PG8_SB(1, 0), cB + kstep, voffB); PG8_STAGE(PG8_SA(1, 0), cA + kstep, voffA); PG8_STAGE(PG8_SB(1, 1), cB + hstepB + kstep, voffB);
    PG8_WAIT_V(6); PG8_BAR;
    for (;;) {
        const bool has_next = S.next(ui + 1, nxt);
        const char* nA = has_next ? (const char*)g.A + (size_t)nxt.pm * tstepA : cA; const char* nB = has_next ? (const char*)g.Bt + (size_t)nxt.pn * tstepB : cB;
        for (int t = 0; t < nt; t += 2) {
            const bool last = (t == nt - 2);
            const char* a1 = cA + (size_t)(t + 1) * kstep;
            const char* a2 = last ? nA : cA + (size_t)(t + 2) * kstep; const char* b2 = last ? nB : cB + (size_t)(t + 2) * kstep;
            const char* a3 = a2 + kstep; const char* b3 = b2 + kstep;
            PG8_LDB(B0, 0, 0); PG8_LDB(B1, 0, 1); PG8_SCHED; PG8_LDA(At, 0, 0); PG8_STAGE(PG8_SA(1, 1), a1 + hstepA, voffA);
            PG8_WAIT_V(8); PG8_WAIT_L(0); PG8_BAR; PG8_MMA(0, 0, At, B0); PG8_MMA(0, 1, At, B1); PG8_BAR; PG8_SCHED;
            PG8_LDA(At, 0, 1); PG8_STAGE(PG8_SB(0, 0), b2, voffB); PG8_STAGE(PG8_SB(0, 1), b2 + hstepB, voffB); PG8_STAGE(PG8_SA(0, 0), a2, voffA);
            PG8_WAIT_V(8); PG8_WAIT_L(0); PG8_BAR; PG8_MMA(1, 0, At, B0); PG8_MMA(1, 1, At, B1); PG8_BAR; PG8_SCHED;
            PG8_LDB(B0, 1, 0); PG8_LDB(B1, 1, 1); PG8_SCHED; PG8_LDA(At, 1, 0); PG8_STAGE(PG8_SA(0, 1), a2 + hstepA, voffA);
            PG8_WAIT_V(8); PG8_WAIT_L(0); PG8_BAR; PG8_MMA(0, 0, At, B0); PG8_MMA(0, 1, At, B1); PG8_BAR; PG8_SCHED;
            PG8_LDA(At, 1, 1); PG8_STAGE(PG8_SB(1, 0), b3, voffB); PG8_STAGE(PG8_SB(1, 1), b3 + hstepB, voffB); PG8_STAGE(PG8_SA(1, 0), a3, voffA);
            PG8_WAIT_V(8); PG8_WAIT_L(0); PG8_BAR; PG8_MMA(1, 0, At, B0); PG8_MMA(1, 1, At, B1); PG8_BAR; PG8_SCHED;
        }
        if (wr == 0) PG8_BAR;
        E(acc, cur, wr, wc, fr, fq);
        if (!has_next) break;
#pragma unroll
        for (int a = 0; a < 2; ++a)
#pragma unroll
            for (int b = 0; b < 2; ++b)
#pragma unroll
                for (int m = 0; m < 4; ++m)
#pragma unroll
                    for (int n = 0; n < 2; ++n) acc[a][b][m][n] = (f32x4){0.f, 0.f, 0.f, 0.f};
        cur = nxt; cA = nA; cB = nB; ++ui;
        if (wr == 1) PG8_BAR;
    }
    PG8_WAIT_V(0);
    PG8_BAR;
#undef PG8_SA
#undef PG8_SB
#undef PG8_STAGE
#undef PG8_LDA
#undef PG8_LDB
#undef PG8_MMA
#undef PG8_WAIT_V
#undef PG8_WAIT_L
#undef PG8_BAR
#undef PG8_SCHED
}
}

#define LAS __attribute__((address_space(3)))
typedef unsigned short bf16;
typedef float f32x4 __attribute__((ext_vector_type(4)));
typedef float f32x16 __attribute__((ext_vector_type(16)));
typedef short bf16x8 __attribute__((ext_vector_type(8)));
typedef unsigned u32x4 __attribute__((ext_vector_type(4)));
typedef unsigned u32x2 __attribute__((ext_vector_type(2)));
using pg8::cvt_pk_bf16;
__device__ __forceinline__ float bf_lo(unsigned u) { return __uint_as_float(u << 16); }
__device__ __forceinline__ float bf_hi(unsigned u) { return __uint_as_float(u & 0xffff0000u); }
__device__ __forceinline__ float wave_sum(float v) {
#pragma unroll
    for (int o = 1; o < 64; o <<= 1) v += __shfl_xor(v, o);
    return v;
}

constexpr size_t MiB = 1u << 20;
constexpr size_t WS_WGU1 = 2 * MiB, WS_WD1 = 46 * MiB, WS_WGU2 = 68 * MiB, WS_WD2 = 112 * MiB, WS_WIN = 134 * MiB, WS_WQ = 147 * MiB + MiB / 2, WS_WK = 149 * MiB, WS_WV = 150 * MiB, WS_WOUT = 151 * MiB;
constexpr size_t WS_SS = 0;
constexpr size_t WS_XB2 = 632 * MiB;
constexpr size_t WS_XN = 160 * MiB;
constexpr size_t WS_Y = WS_XN;
constexpr size_t WS_H = 288 * MiB;
constexpr size_t WS_Z = 288 * MiB;
constexpr size_t WS_QRAW = 496 * MiB;
constexpr size_t WS_KRAW = 632 * MiB;
constexpr size_t WS_VT = 696 * MiB;
constexpr size_t WS_Q = 760 * MiB;
constexpr size_t WS_K = 856 * MiB;
constexpr size_t WS_END = 952 * MiB;
static_assert(WS_WGU1 + (size_t)NGU * DM * 2 <= WS_WD1 && WS_WD1 + (size_t)DM * DFF * 2 <= WS_WGU2 && WS_WGU2 + (size_t)NGU * DM * 2 <= WS_WD2 && WS_WD2 + (size_t)DM * DFF * 2 <= WS_WIN, "ws map 1");
static_assert(WS_WIN + (size_t)ZLD * DM * 2 <= WS_WQ && WS_WQ + (size_t)QW * 512 * 2 <= WS_WK && WS_WK + 1024 * 512 * 2 <= WS_WV && WS_WV + 1024 * 512 * 2 <= WS_WOUT && WS_WOUT + (size_t)DM * DM * 2 <= WS_XN, "ws map 2");
static_assert(WS_XN + (size_t)MTOK * DM * 2 <= WS_H && WS_H + (size_t)MTOK * DFF * 2 <= WS_KRAW && WS_Z + (size_t)MTOK * ZLD * 2 <= WS_QRAW && WS_QRAW + (size_t)MTOK * QW * 2 <= WS_KRAW, "ws map 3");
static_assert(WS_KRAW + (size_t)MTOK * 1024 * 2 <= WS_VT && WS_VT + (size_t)MTOK * 1024 * 2 <= WS_Q && WS_Q + (size_t)MTOK * QW * 2 <= WS_K && WS_K + (size_t)MTOK * QW * 2 <= WS_END, "ws map 4");

__device__ __forceinline__ unsigned f2bf(float f) { unsigned u = __builtin_bit_cast(unsigned, f); return (u + 0x7fffu + ((u >> 16) & 1u)) >> 16; }
__device__ __forceinline__ unsigned pk2(float lo, float hi) { return f2bf(lo) | (f2bf(hi) << 16); }
__device__ __forceinline__ void transpose_item(const float* W, int N, bf16* dst  , int K, int k0, int n0, LAS float* scr, int lane, const float* gk  ) {
    float wv[32];
#pragma unroll
    for (int i = 0; i < 32; ++i) { const int kk = 2 * i + (lane >> 5); wv[i] = W[(size_t)(k0 + kk) * N + n0 + (lane & 31)]; }
    if (gk) {
#pragma unroll
        for (int i = 0; i < 32; ++i) wv[i] *= gk[k0 + 2 * i + (lane >> 5)];
    }
#pragma unroll
    for (int i = 0; i < 32; ++i) { const int kk = 2 * i + (lane >> 5); scr[kk * 33 + (lane & 31)] = wv[i]; }
    asm volatile("s_waitcnt lgkmcnt(0)" ::: "memory");
    const int c = lane & 7;
#pragma unroll
    for (int j = 0; j < 4; ++j) { const int n = (lane >> 3) + 8 * j; const LAS float* s = scr + (8 * c) * 33 + n;
        u32x4 o; o.x = pk2(s[0 * 33], s[1 * 33]); o.y = pk2(s[2 * 33], s[3 * 33]); o.z = pk2(s[4 * 33], s[5 * 33]); o.w = pk2(s[6 * 33], s[7 * 33]);
        *(u32x4*)(dst + (size_t)n * K + k0 + 8 * c) = o; }
    asm volatile("s_waitcnt lgkmcnt(0)" ::: "memory");
}
__device__ __forceinline__ void rms_row_to_bf16(const float* xrow, const float* g, bf16* orow, int lane) {
    const f32x4* xr = (const f32x4*)xrow + lane; const f32x4* gr = (const f32x4*)g + lane;
    f32x4 v[8]; float s = 0.f;
#pragma unroll
    for (int j = 0; j < 8; ++j) { v[j] = xr[64 * j]; s += (v[j].x * v[j].x + v[j].y * v[j].y) + (v[j].z * v[j].z + v[j].w * v[j].w); }
    const float r = 1.0f / sqrtf(wave_sum(s) * (1.0f / DM) + EPS);
    u32x2* o8 = (u32x2*)orow + lane;
#pragma unroll
    for (int j = 0; j < 8; ++j) { const f32x4 gg = gr[64 * j]; u32x2 w; w.x = cvt_pk_bf16(v[j].x * r * gg.x, v[j].y * r * gg.y); w.y = cvt_pk_bf16(v[j].z * r * gg.z, v[j].w * r * gg.w); o8[64 * j] = w; }
}

__device__ __forceinline__ void p0_weights(LAS unsigned char* lds, unsigned char* ws, const float* wg1, const float* wu1, const float* wd1, const float* wg2, const float* wu2, const float* wd2,
                                           const float* win, const float* wq, const float* wkv, const float* wout, const float* g_mix, const float* g_ffn2, const float* g_q, const float* g_kv, int gw, int NGW, int wave, int lane) {
    LAS float* scr = (LAS float*)(lds + wave * 8448);
    constexpr int I_F = (DM / 64) * (DFF / 32);
    constexpr int I_IN = (DM / 64) * (3136 / 32), I_Q = (512 / 64) * (QW / 32), I_KV = (512 / 64) * (2048 / 32), I_O = (DM / 64) * (DM / 32);
    constexpr int NITEMS = 6 * I_F + I_IN + I_Q + I_KV + I_O;
    for (int it = gw; it < NITEMS; it += NGW) {
        int r = it;
        if (r < 6 * I_F) {
            const int which = r / I_F; r -= which * I_F; const int ffn = which / 3, kind = which % 3;
            if (kind < 2) { const float* W = wg1; if (which == 1) W = wu1; if (which == 3) W = wg2; if (which == 4) W = wu2; bf16* D = (bf16*)(ws + (ffn ? WS_WGU2 : WS_WGU1));
                const int nblk = DFF / 32, kb = r / nblk, nb = r % nblk, n0 = nb * 32; const int drow = (n0 / 128) * 256 + (n0 % 128) + kind * 128;
                transpose_item(W, DFF, D + (size_t)drow * DM, DM, kb * 64, n0, scr, lane, ffn ? g_ffn2 : nullptr); }
            else { const float* W = wd1; if (ffn) W = wd2; bf16* D = (bf16*)(ws + (ffn ? WS_WD2 : WS_WD1));
                const int nblk = DM / 32, kb = r / nblk, nb = r % nblk, n0 = nb * 32;
                transpose_item(W, DM, D + (size_t)n0 * DFF, DFF, kb * 64, n0, scr, lane, nullptr); }
            continue;
        }
        r -= 6 * I_F;
        if (r < I_IN) { const int nblk = 3136 / 32, kb = r / nblk, nb = r % nblk, n0 = nb * 32; transpose_item(win, 3136, (bf16*)(ws + WS_WIN) + (size_t)n0 * DM, DM, kb * 64, n0, scr, lane, g_mix); continue; }
        r -= I_IN;
        if (r < I_Q) { const int nblk = QW / 32, kb = r / nblk, nb = r % nblk, n0 = nb * 32; transpose_item(wq, QW, (bf16*)(ws + WS_WQ) + (size_t)n0 * 512, 512, kb * 64, n0, scr, lane, g_q); continue; }
        r -= I_Q;
        if (r < I_KV) { const int nblk = 2048 / 32, kb = r / nblk, nb = r % nblk, n0 = nb * 32; const int h = n0 >> 8, c = n0 & 255;
            bf16* D = (c < 128) ? (bf16*)(ws + WS_WK) + (size_t)(h * 128 + c) * 512 : (bf16*)(ws + WS_WV) + (size_t)(h * 128 + c - 128) * 512;
            transpose_item(wkv, 2048, D, 512, kb * 64, n0, scr, lane, g_kv); continue; }
        r -= I_KV;
        { const int nblk = DM / 32, kb = r / nblk, nb = r % nblk, n0 = nb * 32; transpose_item(wout, DM, (bf16*)(ws + WS_WOUT) + (size_t)n0 * DM, DM, kb * 64, n0, scr, lane, nullptr); }
    }
    { float* ssz = (float*)(ws + WS_SS); for (int i = gw * 64 + lane; i < 5 * MTOK; i += NGW * 64) ssz[i] = 0.f; }
    { u32x4* z = (u32x4*)((bf16*)(ws + WS_WIN) + (size_t)3136 * DM); const int n16 = (ZLD - 3136) * DM * 2 / 16;
      for (int i = gw * 64 + lane; i < n16; i += NGW * 64) z[i] = (u32x4){0u, 0u, 0u, 0u}; }
}

__device__ __forceinline__ void znorm_seg16(bf16* p, const float* g, float invn, int lane, int nvec  ) {
    u32x4 a[2]; float s = 0.f;
#pragma unroll
    for (int j = 0; j < 2; ++j) if (j < nvec) { a[j] = *(const u32x4*)(p + j * 512 + lane * 8);
#pragma unroll
        for (int k = 0; k < 4; ++k) { const float lo = bf_lo(a[j][k]), hi = bf_hi(a[j][k]); s += lo * lo + hi * hi; } }
    const float r = 1.0f / sqrtf(wave_sum(s) * invn + EPS);
#pragma unroll
    for (int j = 0; j < 2; ++j) if (j < nvec) { const f32x4 g0 = *(const f32x4*)(g + j * 512 + lane * 8), g1 = *(const f32x4*)(g + j * 512 + lane * 8 + 4); u32x4 w;
        w.x = cvt_pk_bf16(bf_lo(a[j].x) * r * g0.x, bf_hi(a[j].x) * r * g0.y); w.y = cvt_pk_bf16(bf_lo(a[j].y) * r * g0.z, bf_hi(a[j].y) * r * g0.w);
        w.z = cvt_pk_bf16(bf_lo(a[j].z) * r * g1.x, bf_hi(a[j].z) * r * g1.y); w.w = cvt_pk_bf16(bf_lo(a[j].w) * r * g1.z, bf_hi(a[j].w) * r * g1.w);
        *(u32x4*)(p + j * 512 + lane * 8) = w; }
}

__device__ const double ROPE_REV[32] = {0.15915494309189535, 0.11934937021124886, 0.08949940160889101, 0.06711508300522726, 0.050329212104487035, 0.03774158471741977, 0.0283021958306234, 0.02122365276477766,
    0.015915494309189534, 0.011934937021124886, 0.008949940160889102, 0.006711508300522725, 0.005032921210448704, 0.003774158471741977, 0.00283021958306234, 0.0021223652764777662,
    0.0015915494309189536, 0.0011934937021124885, 0.0008949940160889102, 0.0006711508300522726, 0.0005032921210448703, 0.00037741584717419774, 0.00028302195830623395, 0.0002122365276477766,
    0.00015915494309189535, 0.00011934937021124886, 8.949940160889102e-05, 6.711508300522725e-05, 5.0329212104487035e-05, 3.774158471741978e-05, 2.8302195830623396e-05, 2.122365276477766e-05};
constexpr float QSCALE = 0.07216878364870322f * 1.4426950408889634f;
__device__ __forceinline__ void qk_head(const bf16* nope, const bf16* rope, const float* g, bf16* dst, const float (&cs)[4], const float (&sn)[4], int j, float oscale) {
    const u32x4 a0 = *(const u32x4*)(nope + 16 * j), a1 = *(const u32x4*)(nope + 16 * j + 8);
    const u32x2 r1 = *(const u32x2*)(rope + 4 * j), r2 = *(const u32x2*)(rope + 32 + 4 * j);
    float x[16], y1[4], y2[4];
#pragma unroll
    for (int k = 0; k < 4; ++k) { x[2 * k] = bf_lo(a0[k]); x[2 * k + 1] = bf_hi(a0[k]); x[8 + 2 * k] = bf_lo(a1[k]); x[8 + 2 * k + 1] = bf_hi(a1[k]); }
    y1[0] = bf_lo(r1.x); y1[1] = bf_hi(r1.x); y1[2] = bf_lo(r1.y); y1[3] = bf_hi(r1.y);
    y2[0] = bf_lo(r2.x); y2[1] = bf_hi(r2.x); y2[2] = bf_lo(r2.y); y2[3] = bf_hi(r2.y);
    float s = 0.f;
#pragma unroll
    for (int k = 0; k < 16; ++k) s += x[k] * x[k];
#pragma unroll
    for (int k = 0; k < 4; ++k) s += y1[k] * y1[k] + y2[k] * y2[k];
    s += __shfl_xor(s, 1); s += __shfl_xor(s, 2); s += __shfl_xor(s, 4);
    const float r = 1.0f / sqrtf(s * (1.0f / QKD) + EPS);
    const f32x4 g0 = *(const f32x4*)(g + 16 * j), g1 = *(const f32x4*)(g + 16 * j + 4), g2 = *(const f32x4*)(g + 16 * j + 8), g3 = *(const f32x4*)(g + 16 * j + 12);
    const f32x4 ga = *(const f32x4*)(g + 128 + 4 * j), gb = *(const f32x4*)(g + 160 + 4 * j);
    const float ro = r * oscale;
    u32x4 w0, w1;
    w0.x = cvt_pk_bf16(x[0] * ro * g0.x, x[1] * ro * g0.y); w0.y = cvt_pk_bf16(x[2] * ro * g0.z, x[3] * ro * g0.w); w0.z = cvt_pk_bf16(x[4] * ro * g1.x, x[5] * ro * g1.y); w0.w = cvt_pk_bf16(x[6] * ro * g1.z, x[7] * ro * g1.w);
    w1.x = cvt_pk_bf16(x[8] * ro * g2.x, x[9] * ro * g2.y); w1.y = cvt_pk_bf16(x[10] * ro * g2.z, x[11] * ro * g2.w); w1.z = cvt_pk_bf16(x[12] * ro * g3.x, x[13] * ro * g3.y); w1.w = cvt_pk_bf16(x[14] * ro * g3.z, x[15] * ro * g3.w);
    *(u32x4*)(dst + 16 * j) = w0; *(u32x4*)(dst + 16 * j + 8) = w1;
    float o1[4], o2[4];
#pragma unroll
    for (int k = 0; k < 4; ++k) { const float a = y1[k] * r * ga[k], b = y2[k] * r * gb[k]; o1[k] = (a * cs[k] - b * sn[k]) * oscale; o2[k] = (b * cs[k] + a * sn[k]) * oscale; }
    u32x2 v1, v2; v1.x = cvt_pk_bf16(o1[0], o1[1]); v1.y = cvt_pk_bf16(o1[2], o1[3]); v2.x = cvt_pk_bf16(o2[0], o2[1]); v2.y = cvt_pk_bf16(o2[2], o2[3]);
    *(u32x2*)(dst + 128 + 4 * j) = v1; *(u32x2*)(dst + 160 + 4 * j) = v2;
}
__device__ __forceinline__ void qk_token(int tok, const int* positions, const bf16* Qraw, const bf16* Kraw, const bf16* Z, const float* qg, const float* kg, bf16* Q, bf16* K, int lane) {
    const int h = lane >> 3, j = lane & 7; const int pos = positions[tok];
    float cs[4], sn[4];
#pragma unroll
    for (int k = 0; k < 4; ++k) { const double rev = (double)pos * ROPE_REV[4 * j + k]; const float fr = (float)(rev - __builtin_floor(rev)); cs[k] = __builtin_amdgcn_cosf(fr); sn[k] = __builtin_amdgcn_sinf(fr); }
    qk_head(Qraw + (size_t)tok * QW + h * QKD, Qraw + (size_t)tok * QW + h * QKD + 128, qg, Q + (size_t)tok * QW + h * QKD, cs, sn, j, QSCALE);
    qk_head(Kraw + (size_t)tok * 1024 + h * 128, Z + (size_t)tok * ZLD + 3072, kg, K + (size_t)tok * QW + h * QKD, cs, sn, j, 1.0f);
}

namespace att {
constexpr int KP = 400, VP = 144, KBYTES = 64 * KP, VBYTES = 128 * VP, STAGE = KBYTES + VBYTES;
#define MFMA32(a, b, c) __builtin_amdgcn_mfma_f32_32x32x16_bf16((a), (b), (c), 0, 0, 0)
__device__ __forceinline__ void attn_unit(LAS unsigned char* lds, const bf16* Q, const bf16* K, const bf16* Vt, bf16* Y, const float* gout, int b, int h, int qb, const int tid) {
    const int lane = tid & 63, r32 = lane & 31, hi = lane >> 5; const int wid = __builtin_amdgcn_readfirstlane(tid >> 6);
    const int q0 = qb * 256, qrow = q0 + wid * 32 + r32;
    const size_t tok0 = (size_t)b * SEQ;
    bf16x8 qf[12];
    { const bf16* qp = Q + (tok0 + qrow) * QW + h * QKD + hi * 8;
#pragma unroll
      for (int dk = 0; dk < 12; ++dk) qf[dk] = *(const bf16x8*)(qp + dk * 16); }
    const bf16* ksrc = K + (tok0 + (tid >> 3)) * QW + h * QKD + (tid & 7) * 8;
    const unsigned kdst = (tid >> 3) * KP + (tid & 7) * 16;
    const bf16* vsrc = Vt + (size_t)(h * VD + (tid >> 2)) * MTOK + tok0 + (tid & 3) * 8;
    const unsigned vdst = KBYTES + (tid >> 2) * VP + (tid & 3) * 16;
    const int NT = 4 * (qb + 1), my_last = 4 * qb + (wid >> 1);
    u32x4 kr[3], vr[2];
#pragma unroll
    for (int i = 0; i < 3; ++i) kr[i] = *(const u32x4*)(ksrc + i * 64);
#pragma unroll
    for (int i = 0; i < 2; ++i) vr[i] = *(const u32x4*)(vsrc + i * 32);
    __syncthreads();
#pragma unroll
    for (int i = 0; i < 3; ++i) *(LAS u32x4*)(lds + kdst + i * 128) = kr[i];
#pragma unroll
    for (int i = 0; i < 2; ++i) *(LAS u32x4*)(lds + vdst + i * 64) = vr[i];
    __syncthreads();
    const int pim = (r32 & 16) + ((r32 >> 2) & 1) * 8 + ((r32 >> 3) & 1) * 4 + (r32 & 3);
    const unsigned koff = pim * KP + hi * 16, voff = KBYTES + r32 * VP + hi * 16;
    f32x16 o[4];
#pragma unroll
    for (int d = 0; d < 4; ++d)
#pragma unroll
        for (int r = 0; r < 16; ++r) o[d][r] = 0.f;
    float m_run = -1e30f, l_run = 0.f;
    for (int t = 0; t < NT; ++t) {
        const unsigned bo = (t & 1) * STAGE;
        const bool more = (t + 1 < NT);
        if (more) {
#pragma unroll
            for (int i = 0; i < 3; ++i) kr[i] = *(const u32x4*)(ksrc + (size_t)(t + 1) * 64 * QW + i * 64);
#pragma unroll
            for (int i = 0; i < 2; ++i) vr[i] = *(const u32x4*)(vsrc + (t + 1) * 64 + i * 32);
        }
        if (t <= my_last) {
            f32x16 s0, s1;
#pragma unroll
            for (int r = 0; r < 16; ++r) { s0[r] = 0.f; s1[r] = 0.f; }
#pragma unroll
            for (int dk = 0; dk < 12; ++dk) {
                const bf16x8 k0 = *(const LAS bf16x8*)(lds + bo + koff + dk * 32), k1 = *(const LAS bf16x8*)(lds + bo + koff + 32 * KP + dk * 32);
                s0 = MFMA32(k0, qf[dk], s0); s1 = MFMA32(k1, qf[dk], s1);
            }
            if (t >= 4 * qb) {
                const int kb0 = 64 * t + 8 * hi;
#pragma unroll
                for (int r = 0; r < 16; ++r) { const int key = kb0 + 16 * (r >> 3) + (r & 7); if (key > qrow) s0[r] = -1e30f; if (key + 32 > qrow) s1[r] = -1e30f; }
            }
            float mx = s0[0];
#pragma unroll
            for (int r = 1; r < 16; ++r) mx = fmaxf(mx, s0[r]);
#pragma unroll
            for (int r = 0; r < 16; ++r) mx = fmaxf(mx, s1[r]);
            mx = fmaxf(mx, __shfl_xor(mx, 32));
            const float m_new = fmaxf(m_run, mx), alpha = __builtin_amdgcn_exp2f(m_run - m_new);
            m_run = m_new;
            float ls = 0.f;
#pragma unroll
            for (int r = 0; r < 16; ++r) { s0[r] = __builtin_amdgcn_exp2f(s0[r] - m_new); s1[r] = __builtin_amdgcn_exp2f(s1[r] - m_new); ls += s0[r] + s1[r]; }
            l_run = l_run * alpha + ls;
#pragma unroll
            for (int d = 0; d < 4; ++d)
#pragma unroll
                for (int r = 0; r < 16; ++r) o[d][r] *= alpha;
            u32x4 pw[4];
#pragma unroll
            for (int c = 0; c < 2; ++c) {
                pw[c] = (u32x4){cvt_pk_bf16(s0[8 * c], s0[8 * c + 1]), cvt_pk_bf16(s0[8 * c + 2], s0[8 * c + 3]), cvt_pk_bf16(s0[8 * c + 4], s0[8 * c + 5]), cvt_pk_bf16(s0[8 * c + 6], s0[8 * c + 7])};
                pw[2 + c] = (u32x4){cvt_pk_bf16(s1[8 * c], s1[8 * c + 1]), cvt_pk_bf16(s1[8 * c + 2], s1[8 * c + 3]), cvt_pk_bf16(s1[8 * c + 4], s1[8 * c + 5]), cvt_pk_bf16(s1[8 * c + 6], s1[8 * c + 7])};
            }
#pragma unroll
            for (int kc = 0; kc < 4; ++kc) {
                const bf16x8 pf = __builtin_bit_cast(bf16x8, pw[kc]);
#pragma unroll
                for (int d = 0; d < 4; ++d) { const bf16x8 vf = *(const LAS bf16x8*)(lds + bo + voff + d * 32 * VP + kc * 32); o[d] = MFMA32(vf, pf, o[d]); }
            }
        }
        if (more) {
            const unsigned nb = ((t + 1) & 1) * STAGE;
#pragma unroll
            for (int i = 0; i < 3; ++i) *(LAS u32x4*)(lds + nb + kdst + i * 128) = kr[i];
#pragma unroll
            for (int i = 0; i < 2; ++i) *(LAS u32x4*)(lds + nb + vdst + i * 64) = vr[i];
        }
        __syncthreads();
    }
    const float l = l_run + __shfl_xor(l_run, 32), inv = 1.0f / l;
    float ss = 0.f;
#pragma unroll
    for (int d = 0; d < 4; ++d)
#pragma unroll
        for (int r = 0; r < 16; ++r) { o[d][r] *= inv; ss += o[d][r] * o[d][r]; }
    ss += __shfl_xor(ss, 32);
    const float rn = 1.0f / sqrtf(ss * (1.0f / VD) + EPS);
    bf16* yp = Y + (tok0 + qrow) * DM + 1024 + h * VD + 4 * hi; const float* gp = gout + h * VD + 4 * hi;
#pragma unroll
    for (int d = 0; d < 4; ++d)
#pragma unroll
        for (int r4 = 0; r4 < 4; ++r4) { const f32x4 g = *(const f32x4*)(gp + 32 * d + 8 * r4); u32x2 w;
            w.x = cvt_pk_bf16(o[d][4 * r4] * rn * g.x, o[d][4 * r4 + 1] * rn * g.y); w.y = cvt_pk_bf16(o[d][4 * r4 + 2] * rn * g.z, o[d][4 * r4 + 3] * rn * g.w);
            *(u32x2*)(yp + 32 * d + 8 * r4) = w; }
}
}

namespace gm {
constexpr int WP = 272;
constexpr int WBYTES = 128 * WP;
__device__ __forceinline__ void gmlp_phase(LAS unsigned char* lds, const bf16* Z, const float* w_s, const float* b_s, const float* gout, const float* ssv, const float* gv, bf16* Y, int vcu, int G, const int tid) {
    const int lane = tid & 63, l16 = lane & 15, q4 = lane >> 4; const int wid = __builtin_amdgcn_readfirstlane(tid >> 6);
    int gcur = -1;
    for (int un = vcu; un < 2048; un += G) {
        const int g = un & 7, bc = un >> 3;
        const size_t tok0 = (size_t)bc * 128;
        __syncthreads();
        if (g != gcur) {
            gcur = g;
#pragma unroll
            for (int i = 0; i < 8; ++i) { const int p = tid + 512 * i, t = p >> 5, s = (p & 31) * 4; const f32x4 w = *(const f32x4*)(w_s + (size_t)g * 16384 + t * 128 + s);
                u32x2 o; o.x = cvt_pk_bf16(s <= t ? w.x : 0.f, s + 1 <= t ? w.y : 0.f); o.y = cvt_pk_bf16(s + 2 <= t ? w.z : 0.f, s + 3 <= t ? w.w : 0.f);
                *(LAS u32x2*)(lds + t * WP + s * 2) = o; }
        }
#pragma unroll
        for (int i = 0; i < 4; ++i) { const int p = tid + 512 * i, s = p >> 4, seg = p & 15; const u32x4 v = *(const u32x4*)(Z + (tok0 + s) * ZLD + 1024 + g * 128 + seg * 8);
            const float rv = __builtin_amdgcn_rsqf(ssv[tok0 + s] * (1.0f / 1024.0f) + EPS); const f32x4 g0 = *(const f32x4*)(gv + g * 128 + seg * 8), g1 = *(const f32x4*)(gv + g * 128 + seg * 8 + 4);
            LAS unsigned short* dst = (LAS unsigned short*)(lds + WBYTES + (seg * 8) * WP + s * 2);
            const unsigned w0 = cvt_pk_bf16(bf_lo(v.x) * rv * g0.x, bf_hi(v.x) * rv * g0.y), w1 = cvt_pk_bf16(bf_lo(v.y) * rv * g0.z, bf_hi(v.y) * rv * g0.w);
            const unsigned w2 = cvt_pk_bf16(bf_lo(v.z) * rv * g1.x, bf_hi(v.z) * rv * g1.y), w3 = cvt_pk_bf16(bf_lo(v.w) * rv * g1.z, bf_hi(v.w) * rv * g1.w);
            dst[0 * (WP / 2)] = (unsigned short)(w0 & 0xffffu); dst[1 * (WP / 2)] = (unsigned short)(w0 >> 16); dst[2 * (WP / 2)] = (unsigned short)(w1 & 0xffffu); dst[3 * (WP / 2)] = (unsigned short)(w1 >> 16);
            dst[4 * (WP / 2)] = (unsigned short)(w2 & 0xffffu); dst[5 * (WP / 2)] = (unsigned short)(w2 >> 16); dst[6 * (WP / 2)] = (unsigned short)(w3 & 0xffffu); dst[7 * (WP / 2)] = (unsigned short)(w3 >> 16); }
        __syncthreads();
        pg8::f32x4 acc[8];
#pragma unroll
        for (int d = 0; d < 8; ++d) acc[d] = (pg8::f32x4){0.f, 0.f, 0.f, 0.f};
        const int nsb = (wid >> 1) + 1;
        for (int sb = 0; sb < nsb; ++sb) {
            const bf16x8 wf = *(const LAS bf16x8*)(lds + (16 * wid + l16) * WP + sb * 64 + q4 * 16);
#pragma unroll
            for (int d = 0; d < 8; ++d) { const bf16x8 vf = *(const LAS bf16x8*)(lds + WBYTES + (16 * d + l16) * WP + sb * 64 + q4 * 16); acc[d] = __builtin_amdgcn_mfma_f32_16x16x32_bf16(vf, wf, acc[d], 0, 0, 0); }
        }
        const int t = 16 * wid + l16; const float bs = b_s[g * 128 + t];
        const bf16* up = Z + (tok0 + t) * ZLD + g * 128 + 4 * q4;
        float ss = 0.f;
#pragma unroll
        for (int d = 0; d < 8; ++d) { const u32x2 uu = *(const u32x2*)(up + 16 * d);
            acc[d][0] = bf_lo(uu.x) * (acc[d][0] + bs); acc[d][1] = bf_hi(uu.x) * (acc[d][1] + bs); acc[d][2] = bf_lo(uu.y) * (acc[d][2] + bs); acc[d][3] = bf_hi(uu.y) * (acc[d][3] + bs);
            ss += (acc[d][0] * acc[d][0] + acc[d][1] * acc[d][1]) + (acc[d][2] * acc[d][2] + acc[d][3] * acc[d][3]); }
        ss += __shfl_xor(ss, 16); ss += __shfl_xor(ss, 32);
        const float rn = 1.0f / sqrtf(ss * (1.0f / 128.0f) + EPS);
        bf16* yp = Y + (tok0 + t) * DM + g * 128 + 4 * q4; const float* gp = gout + g * 128 + 4 * q4;
#pragma unroll
        for (int d = 0; d < 8; ++d) { const f32x4 gg = *(const f32x4*)(gp + 16 * d); u32x2 w; w.x = cvt_pk_bf16(acc[d][0] * rn * gg.x, acc[d][1] * rn * gg.y); w.y = cvt_pk_bf16(acc[d][2] * rn * gg.z, acc[d][3] * rn * gg.w);
            *(u32x2*)(yp + 16 * d) = w; }
    }
}
}

constexpr int LDS_BYTES = 147456;
constexpr int NPHASE = 10;
#ifndef DUP_MASK
#define DUP_MASK 0
#endif
struct Args { const float* in[24]; float* out; unsigned char* ws; int ph_lo, ph_hi; };

__global__ void __launch_bounds__(512, 2) fwd_megakernel(Args a) {
    extern __shared__ __attribute__((aligned(16))) unsigned char lds_raw[];
    LAS unsigned char* lds = (LAS unsigned char*)lds_raw;
    cg::grid_group grid = cg::this_grid();
    const int G = gridDim.x, bx = blockIdx.x; const int vcu = (G % 8 == 0) ? (bx % 8) * (G / 8) + bx / 8 : bx;
    const int NGW = G * 8;
    for (int ph = a.ph_lo; ph < a.ph_hi; ++ph) {
    int rep = 0;
phase_again:
    int tid = threadIdx.x; asm volatile("" : "+v"(tid));
    unsigned char* ws = a.ws; asm volatile("" : "+s"(ws)); float* out = a.out; asm volatile("" : "+s"(out));
    const int lane = tid & 63, wave = __builtin_amdgcn_readfirstlane(tid >> 6), gw = vcu * 8 + wave;
    bf16* XN = (bf16*)(ws + WS_XN); bf16* Yb = (bf16*)(ws + WS_Y); bf16* H = (bf16*)(ws + WS_H); bf16* Z = (bf16*)(ws + WS_Z);
    bf16* QRAW = (bf16*)(ws + WS_QRAW); bf16* KRAW = (bf16*)(ws + WS_KRAW); bf16* VT = (bf16*)(ws + WS_VT); bf16* Qb = (bf16*)(ws + WS_Q); bf16* Kb = (bf16*)(ws + WS_K);
        const bool is_gemm = (ph == 1 || ph == 2 || ph == 3 || ph == 4 || ph == 7 || ph == 8 || ph == 9);
        float* SS = (float*)(ws + WS_SS);
        if (is_gemm) {
            const int nsub = (ph == 4) ? 3 : 1;
            for (int sub = 0; sub < nsub; ++sub) {
                pg8::Gemm g; pg8::Epi E; E.mode = 0; E.O = nullptr; E.ldc = 0; E.base = nullptr; E.out = nullptr; E.alpha = 0.f; E.rs = nullptr; E.rs_invn = 1.0f / DM; E.xb = nullptr; E.ss_out = nullptr;
                if (ph == 1) { g = pg8::Gemm{XN, (const bf16*)(ws + WS_WGU1), MTOK, NGU, DM, DM, DM}; E.mode = 2; E.O = H; E.ldc = DFF; }
                else if (ph == 8) { g = pg8::Gemm{(const bf16*)(ws + WS_XB2), (const bf16*)(ws + WS_WGU2), MTOK, NGU, DM, DM, DM}; E.mode = 2; E.O = H; E.ldc = DFF; E.rs = SS + MTOK; }
                else if (ph == 2) { g = pg8::Gemm{H, (const bf16*)(ws + WS_WD1), MTOK, DM, DFF, DFF, DFF}; E.mode = 3; E.base = a.in[0]; E.out = out; E.ldc = DM; E.alpha = 0.5f; E.xb = XN; E.ss_out = SS; }
                else if (ph == 9) { g = pg8::Gemm{H, (const bf16*)(ws + WS_WD2), MTOK, DM, DFF, DFF, DFF}; E.mode = 3; E.base = out; E.out = out; E.ldc = DM; E.alpha = 0.5f; }
                else if (ph == 3) { g = pg8::Gemm{XN, (const bf16*)(ws + WS_WIN), MTOK, ZLD, DM, DM, DM}; E.mode = 1; E.O = Z; E.ldc = ZLD; E.rs = SS; E.ss_out = SS + 2 * MTOK; }
                else if (ph == 7) { g = pg8::Gemm{Yb, (const bf16*)(ws + WS_WOUT), MTOK, DM, DM, DM, DM}; E.mode = 3; E.base = out; E.out = out; E.ldc = DM; E.alpha = 1.0f; E.xb = (bf16*)(ws + WS_XB2); E.ss_out = SS + MTOK; }
                else if (sub == 0) { g = pg8::Gemm{Z + 2048, (const bf16*)(ws + WS_WQ), MTOK, QW, 512, ZLD, 512}; E.O = QRAW; E.ldc = QW; E.rs = SS + 3 * MTOK; E.rs_invn = 1.0f / 512.0f; }
                else if (sub == 1) { g = pg8::Gemm{Z + 2560, (const bf16*)(ws + WS_WK), MTOK, 1024, 512, ZLD, 512}; E.O = KRAW; E.ldc = 1024; E.rs = SS + 4 * MTOK; E.rs_invn = 1.0f / 512.0f; }
                else { g = pg8::Gemm{(const bf16*)(ws + WS_WV), Z + 2560, 1024, MTOK, 512, 512, ZLD}; E.mode = 4; E.O = VT; E.ldc = MTOK; E.rs = SS + 4 * MTOK; E.rs_invn = 1.0f / 512.0f; }
                pg8::StaticOrder S; S.init(g.M, g.N, G, bx);
#ifndef NO_GEMM
                pg8::gemm_phase(lds, g, S, E, tid);
#endif
            }
#ifndef NO_GM
            if (ph == 4) gm::gmlp_phase(lds, Z, a.in[9], a.in[10], a.in[17], SS + 2 * MTOK, a.in[8], Yb, vcu, G, tid);
#endif
        } else if (ph == 0) {
            p0_weights(lds, ws, a.in[3], a.in[4], a.in[5], a.in[21], a.in[22], a.in[23], a.in[7], a.in[12], a.in[14], a.in[19], a.in[6], a.in[20], a.in[11], a.in[13], gw, NGW, wave, lane);
            for (int m = gw; m < MTOK; m += NGW) rms_row_to_bf16(a.in[0] + (size_t)m * DM, a.in[2], XN + (size_t)m * DM, lane);
        } else if (ph == 5) {
            for (int m = gw; m < MTOK; m += NGW) qk_token(m, (const int*)a.in[1], QRAW, KRAW, Z, a.in[15], a.in[16], Qb, Kb, lane);
        } else if (ph == 6) {
            for (int v = vcu; v < 256; v += G) { const int bh = v >> 1, s0 = (v & 1) * 2;
#pragma unroll 1
                for (int i = 0; i < 4; ++i) { const int qb = (i == 0) ? 7 - s0 : (i == 1) ? s0 : (i == 2) ? 6 - s0 : s0 + 1;
#ifndef NO_ATT
                    att::attn_unit(lds, Qb, Kb, VT, Yb, a.in[18], bh >> 3, bh & 7, qb, tid);
#endif
                } }
        }
        if (ph + 1 < a.ph_hi) grid.sync();
#if DUP_MASK
        if (((DUP_MASK >> ph) & 1) && rep == 0) { rep = 1; if (ph + 1 >= a.ph_hi) grid.sync(); goto phase_again; }
#endif
    }
}

extern "C" void kernel_launch(void* const* d_in, const int* in_sizes, int n_in, void* d_out, int out_size, void* d_ws, size_t ws_size, hipStream_t stream) {
    static int grid = 0;
    if (grid == 0) {
        if (n_in != 24 || out_size != MTOK * DM || ws_size < WS_END) { fprintf(stderr, "kernel_launch: unexpected problem (n_in %d, out %d, ws %zu); nothing launched\n", n_in, out_size, ws_size); grid = -1; return; }
        int dev = 0, cus = 0, per_cu = 0;
        if (hipGetDevice(&dev) != hipSuccess || hipDeviceGetAttribute(&cus, hipDeviceAttributeMultiprocessorCount, dev) != hipSuccess) { grid = -1; return; }
        if (hipFuncSetAttribute((const void*)fwd_megakernel, hipFuncAttributeMaxDynamicSharedMemorySize, LDS_BYTES) != hipSuccess) { fprintf(stderr, "kernel_launch: hipFuncSetAttribute failed\n"); grid = -1; return; }
        if (hipOccupancyMaxActiveBlocksPerMultiprocessor(&per_cu, (const void*)fwd_megakernel, 512, LDS_BYTES) != hipSuccess || per_cu < 1) { fprintf(stderr, "kernel_launch: occupancy query says %d\n", per_cu); per_cu = 1; }
        (void)hipGetLastError();
        grid = cus * per_cu;
        if (grid % 8 != 0 || grid > 2048) grid = cus;
    }
    if (grid < 0) return;
    Args a{};
    for (int i = 0; i < 24; ++i) a.in[i] = (const float*)d_in[i];
    a.out = (float*)d_out; a.ws = (unsigned char*)d_ws;
#if MK_MULTI
    for (int ph = 0; ph < NPHASE; ++ph) { a.ph_lo = ph; a.ph_hi = ph + 1; hipLaunchKernelGGL(fwd_megakernel, dim3(grid), dim3(512), LDS_BYTES, stream, a); }
#else
    a.ph_lo = 0; a.ph_hi = NPHASE;
    void* args[] = {&a};
    hipError_t e = hipLaunchCooperativeKernel((const void*)fwd_megakernel, dim3(grid), dim3(512), args, LDS_BYTES, stream);
    if (e != hipSuccess) fprintf(stderr, "kernel_launch: cooperative launch failed: %s (grid %d)\n", hipGetErrorString(e), grid);
#endif
}
```

```cpp
#include <hip/hip_runtime.h>
#include <hip/hip_cooperative_groups.h>
#include <cstdio>
#include <cstdint>
namespace cg = cooperative_groups;

#ifndef MK_MULTI
#define MK_MULTI 0
#endif

constexpr int BATCH = 16, SEQ = 2048, DM = 2048, MTOK = BATCH * SEQ, DFF = 5504, NGU = 2 * DFF;
constexpr int ZLD = 3328;
constexpr int NH = 8, QKD = 192, VD = 128, QW = NH * QKD  ;
constexpr float EPS = 1e-6f;

namespace pg8 {
#define PG8_LAS __attribute__((address_space(3)))
typedef unsigned short bf16_t;
typedef short bf16x8 __attribute__((ext_vector_type(8)));
typedef float f32x4 __attribute__((ext_vector_type(4)));
typedef float f32x2 __attribute__((ext_vector_type(2)));
typedef unsigned u32x4 __attribute__((ext_vector_type(4)));
typedef unsigned u32x2 __attribute__((ext_vector_type(2)));
typedef __bf16 bf16x2_t __attribute__((ext_vector_type(2)));
constexpr int BM = 256, BK = 64, HALF = 128, HTB = HALF * BK * 2  , STAGE_BYTES = 8 * HTB, NXCD = 8, WGM = 8;

__host__ __device__ __forceinline__ int lds_byte(int r, int c) { const int st = (r >> 4) * 2 + (c >> 5), rr = r & 15, cc = c & 31, ob = rr * 64 + cc * 2; return st * 1024 + (ob ^ (((ob >> 9) & 1) << 5)); }
__host__ __device__ __forceinline__ void stage_rc(int b, int& R, int& C) { const int st = b / 1024, sb = b % 1024, swz = sb ^ (((sb >> 9) & 1) << 5); R = (st >> 1) * 16 + swz / 64; C = (st & 1) * 32 + (swz % 64) / 2; }
__host__ __device__ __forceinline__ int perm32(int rho) { const int n = rho >> 4, i = rho & 15; return 8 * (i >> 2) + 4 * n + (i & 3); }

struct Unit { int pm, pn; };
struct Gemm { const bf16_t* A; const bf16_t* Bt; int M, N, K, lda, ldb; };

struct StaticOrder {
    int nM, nN, nwg, G, c, wgm;
    __host__ __device__ void init(int M, int N, int G_, int c_, int wgm_) { nM = M / BM; nN = N / BM; nwg = nM * nN; G = G_; c = c_; wgm = wgm_; }
    __host__ __device__ bool next(int i, Unit& u) const {
        const long L = (long)i * G + c; if (L >= nwg) return false;
        int wgid = (int)L; { const int q = nwg / NXCD, r = nwg % NXCD, xcd = wgid % NXCD, off = wgid / NXCD; wgid = (xcd < r ? xcd * (q + 1) : r * (q + 1) + (xcd - r) * q) + off; }
        const int nig = wgm * nN, gid = wgid / nig, fm = gid * wgm, gsz = (nM - fm) < wgm ? (nM - fm) : wgm;
        u.pm = fm + ((wgid % nig) % gsz); u.pn = (wgid % nig) / gsz; return true;
    }
};

__device__ __forceinline__ unsigned cvt_pk_bf16(float lo, float hi) { f32x2 v = {lo, hi}; bf16x2_t b = __builtin_convertvector(v, bf16x2_t); return __builtin_bit_cast(unsigned, b); }
__device__ __forceinline__ f32x2 gelu_pk(f32x2 v) {
    const f32x2 av = __builtin_elementwise_abs(v), d = av * 0.2316418882f + 1.0f;
    f32x2 t; t.x = __builtin_amdgcn_rcpf(d.x); t.y = __builtin_amdgcn_rcpf(d.y);
    f32x2 q = t * 0.5307027145f + (-0.7265760135f); q = q * t + 0.7107068705f; q = q * t + (-0.142248368f); q = q * t + 0.127414796f; q = q * t;
    const f32x2 s = (v * v) * (-0.72134752044f);
    f32x2 e; e.x = __builtin_amdgcn_exp2f(s.x); e.y = __builtin_amdgcn_exp2f(s.y);
    const f32x2 m = v * (q * e), r = v - m;
    f32x2 o; o.x = v.x < 0.f ? m.x : r.x; o.y = v.y < 0.f ? m.y : r.y; return o;
}
__device__ __forceinline__ f32x4 gelu4(f32x4 v) { f32x2 a = gelu_pk((f32x2){v[0], v[1]}), b = gelu_pk((f32x2){v[2], v[3]}); return (f32x4){a.x, a.y, b.x, b.y}; }
__device__ __forceinline__ float silu_mul(float g, float u) { return g * u * __builtin_amdgcn_rcpf(1.0f + __builtin_amdgcn_exp2f(-1.4426950408889634f * g)); }

struct Epi {
    int mode; bf16_t* O; int ldc; const float* base; const bf16_t* base_bf; float* out; float alpha; const float* rs; float rs_invn; bf16_t* xb; float* ss_out;
    __device__ __forceinline__ void operator()(const f32x4 (&acc)[2][2][4][2], const Unit& u, int wr, int wc, int fr, int fq) const {
        const int row0 = u.pm * BM + wr * 64 + fr;
#ifdef FORCE_MODE
        const int mode = FORCE_MODE;
#endif
        if (mode == 3) {
            const int col0 = u.pn * BM + wc * 32 + 8 * fq;
#pragma unroll
            for (int ai = 0; ai < 2; ++ai)
#pragma unroll
                for (int m = 0; m < 4; ++m) { const int row = row0 + ai * HALF + m * 16; const size_t off = (size_t)row * ldc + col0; float ssr = 0.f;
#pragma unroll
                    for (int bj = 0; bj < 2; ++bj) { f32x4 b0, b1;
                        if (base_bf) { const u32x4 t = *(const u32x4*)(base_bf + off + bj * HALF);
                            b0 = (f32x4){__uint_as_float(t.x << 16), __uint_as_float(t.x & 0xffff0000u), __uint_as_float(t.y << 16), __uint_as_float(t.y & 0xffff0000u)};
                            b1 = (f32x4){__uint_as_float(t.z << 16), __uint_as_float(t.z & 0xffff0000u), __uint_as_float(t.w << 16), __uint_as_float(t.w & 0xffff0000u)}; }
                        else { b0 = *(const f32x4*)(base + off + bj * HALF); b1 = *(const f32x4*)(base + off + bj * HALF + 4); }
                        const f32x4 o0 = b0 + acc[ai][bj][m][0] * alpha, o1 = b1 + acc[ai][bj][m][1] * alpha;
                        if (out) { *(f32x4*)(out + off + bj * HALF) = o0; *(f32x4*)(out + off + bj * HALF + 4) = o1; }
                        if (xb) { ssr += (o0[0] * o0[0] + o0[1] * o0[1]) + (o0[2] * o0[2] + o0[3] * o0[3]) + (o1[0] * o1[0] + o1[1] * o1[1]) + (o1[2] * o1[2] + o1[3] * o1[3]);
                            u32x4 w; w.x = cvt_pk_bf16(o0[0], o0[1]); w.y = cvt_pk_bf16(o0[2], o0[3]); w.z = cvt_pk_bf16(o1[0], o1[1]); w.w = cvt_pk_bf16(o1[2], o1[3]); *(u32x4*)(xb + off + bj * HALF) = w; } }
                    if (xb) { ssr += __shfl_xor(ssr, 16); ssr += __shfl_xor(ssr, 32); if (fq == 0) atomicAdd(ss_out + row, ssr); }
                    if (m == 3) asm volatile("" ::: "memory"); }
            return;
        }
        f32x4 cs[2][2];
#pragma unroll
        for (int bj = 0; bj < 2; ++bj)
#pragma unroll
            for (int n = 0; n < 2; ++n) cs[bj][n] = (f32x4){1.f, 1.f, 1.f, 1.f};
        if (mode == 4) {
            const int c0 = u.pn * BM + wc * 32 + 8 * fq;
#pragma unroll
            for (int bj = 0; bj < 2; ++bj)
#pragma unroll
                for (int n = 0; n < 2; ++n) { const f32x4 s = *(const f32x4*)(rs + c0 + bj * HALF + 4 * n);
#pragma unroll
                    for (int i = 0; i < 4; ++i) cs[bj][n][i] = __builtin_amdgcn_rsqf(s[i] * rs_invn + 1e-6f); }
        }
        const bool rowscale = (rs != nullptr) && (mode != 4);
        const bool act = (mode == 1) && (u.pn < 8), stat = (mode == 1) && (u.pn >= 4) && (u.pn < 12);
        float* ssp = ss_out + (u.pn < 8 ? 0 : (u.pn < 10 ? 32768 : 65536));
        const int col0 = (mode == 2 ? u.pn * HALF : u.pn * BM) + wc * 32 + 8 * fq;
#pragma unroll
        for (int ai = 0; ai < 2; ++ai)
#pragma unroll
            for (int m = 0; m < 4; ++m) { const int row = row0 + ai * HALF + m * 16; bf16_t* rowp = O + (size_t)row * ldc + col0;
                float r = 1.0f; if (rowscale) r = __builtin_amdgcn_rsqf(rs[row] * rs_invn + 1e-6f);
                if (mode == 2) {
                    const f32x4 g0 = acc[ai][0][m][0] * r, g1 = acc[ai][0][m][1] * r, u0 = acc[ai][1][m][0] * r, u1 = acc[ai][1][m][1] * r;
                    u32x4 w; w.x = cvt_pk_bf16(silu_mul(g0[0], u0[0]), silu_mul(g0[1], u0[1])); w.y = cvt_pk_bf16(silu_mul(g0[2], u0[2]), silu_mul(g0[3], u0[3]));
                    w.z = cvt_pk_bf16(silu_mul(g1[0], u1[0]), silu_mul(g1[1], u1[1])); w.w = cvt_pk_bf16(silu_mul(g1[2], u1[2]), silu_mul(g1[3], u1[3]));
                    *(u32x4*)rowp = w;
                } else {
                    float ssr = 0.f;
#pragma unroll
                    for (int bj = 0; bj < 2; ++bj) { f32x4 v0 = acc[ai][bj][m][0] * cs[bj][0] * r, v1 = acc[ai][bj][m][1] * cs[bj][1] * r;
                        if (act) { v0 = gelu4(v0); v1 = gelu4(v1); }
                        ssr += (v0[0] * v0[0] + v0[1] * v0[1]) + (v0[2] * v0[2] + v0[3] * v0[3]) + (v1[0] * v1[0] + v1[1] * v1[1]) + (v1[2] * v1[2] + v1[3] * v1[3]);
                        u32x4 w; w.x = cvt_pk_bf16(v0[0], v0[1]); w.y = cvt_pk_bf16(v0[2], v0[3]); w.z = cvt_pk_bf16(v1[0], v1[1]); w.w = cvt_pk_bf16(v1[2], v1[3]);
                        *(u32x4*)(rowp + bj * HALF) = w; }
                    if (stat) { ssr += __shfl_xor(ssr, 16); ssr += __shfl_xor(ssr, 32); if (fq == 0) atomicAdd(ssp + row, ssr); }
                }
            }
    }
};

__device__ __forceinline__ void gemm_phase(PG8_LAS unsigned char* lds, const Gemm g, const StaticOrder& S, const Epi& E, const int tid) {
    const int wid = __builtin_amdgcn_readfirstlane(tid >> 6), lane = tid & 63, wr = wid >> 2, wc = wid & 3, fr = lane & 15, fq = lane >> 4;
    const int K = g.K, nt = K / BK;
    unsigned voffA[2], voffB[2];
#pragma unroll
    for (int i = 0; i < 2; ++i) { int R, C; stage_rc(tid * 16 + i * 8192, R, C); const int Rb = (R & ~31) + perm32(R & 31);
        voffA[i] = (unsigned)(R * g.lda + C) * 2u; voffB[i] = (unsigned)(Rb * g.ldb + C) * 2u; }
    const size_t kstep = (size_t)(BK * 2);
    const size_t hstepA = (size_t)HALF * g.lda * 2, hstepB = (size_t)HALF * g.ldb * 2;
    const size_t tstepA = 2 * hstepA, tstepB = 2 * hstepB;
    const unsigned ldsw = (unsigned)wid * 1024u;
    const int aoff = lds_byte(wr * 64 + fr, fq * 8), boff = lds_byte(wc * 32 + fr, fq * 8);
#define PG8_SA(b, h) (((b) * 2 + (h)) * HTB)
#define PG8_SB(b, h) ((4 + (b) * 2 + (h)) * HTB)
#define PG8_STAGE(bufoff, gbase, voff) do { _Pragma("unroll") for (int _i = 0; _i < 2; ++_i) \
        __builtin_amdgcn_global_load_lds((const unsigned*)((const char*)(gbase) + (voff)[_i]), (PG8_LAS unsigned*)(lds + (bufoff) + ldsw + _i * 8192), 16, 0, 0); } while (0)
#define PG8_LDA(dst, b, h) do { _Pragma("unroll") for (int m = 0; m < 4; ++m) _Pragma("unroll") for (int k = 0; k < 2; ++k) dst[m][k] = *(const PG8_LAS bf16x8*)(lds + PG8_SA(b, h) + aoff + m * 2048 + k * 1024); } while (0)
#define PG8_LDB(dst, b, h) do { _Pragma("unroll") for (int n = 0; n < 2; ++n) _Pragma("unroll") for (int k = 0; k < 2; ++k) dst[n][k] = *(const PG8_LAS bf16x8*)(lds + PG8_SB(b, h) + boff + n * 2048 + k * 1024); } while (0)
#define PG8_MMA(ai, bj, At, Bt) do { __builtin_amdgcn_s_setprio(1); _Pragma("unroll") for (int m = 0; m < 4; ++m) _Pragma("unroll") for (int n = 0; n < 2; ++n) _Pragma("unroll") for (int k = 0; k < 2; ++k) \
        acc[ai][bj][m][n] = __builtin_amdgcn_mfma_f32_16x16x32_bf16(Bt[n][k], At[m][k], acc[ai][bj][m][n], 0, 0, 0); __builtin_amdgcn_s_setprio(0); } while (0)
#define PG8_WAIT_V(n) asm volatile("s_waitcnt vmcnt(" #n ")" ::: "memory")
#define PG8_WAIT_L(n) asm volatile("s_waitcnt lgkmcnt(" #n ")" ::: "memory")
#define PG8_BAR __builtin_amdgcn_s_barrier()
#define PG8_SCHED __builtin_amdgcn_sched_barrier(0)
    Unit cur, nxt; int ui = 0;
    if (!S.next(0, cur)) return;
    f32x4 acc[2][2][4][2];
#pragma unroll
    for (int a = 0; a < 2; ++a)
#pragma unroll
        for (int b = 0; b < 2; ++b)
#pragma unroll
            for (int m = 0; m < 4; ++m)
#pragma unroll
                for (int n = 0; n < 2; ++n) acc[a][b][m][n] = (f32x4){0.f, 0.f, 0.f, 0.f};
    bf16x8 At[4][2], B0[2][2], B1[2][2];
    const char* cA = (const char*)g.A + (size_t)cur.pm * tstepA; const char* cB = (const char*)g.Bt + (size_t)cur.pn * tstepB;
    PG8_STAGE(PG8_SB(0, 0), cB, voffB); PG8_STAGE(PG8_SB(0, 1), cB + hstepB, voffB); PG8_STAGE(PG8_SA(0, 0), cA, voffA); PG8_STAGE(PG8_SA(0, 1), cA + hstepA, voffA);
    if (wr == 1) PG8_BAR;
    PG8_WAIT_V(2); PG8_BAR;
    PG8_STAGE(PG8_SB(1, 0), cB + kstep, voffB); PG8_STAGE(PG8_SA(1, 0), cA + kstep, voffA); PG8_STAGE(PG8_SB(1, 1), cB + hstepB + kstep, voffB);
    PG8_WAIT_V(6); PG8_BAR;
    for (;;) {
        const bool has_next = S.next(ui + 1, nxt);
        const char* nA = has_next ? (const char*)g.A + (size_t)nxt.pm * tstepA : cA; const char* nB = has_next ? (const char*)g.Bt + (size_t)nxt.pn * tstepB : cB;
        for (int t = 0; t < nt; t += 2) {
            const bool last = (t == nt - 2);
            const char* a1 = cA + (size_t)(t + 1) * kstep;
            const char* a2 = last ? nA : cA + (size_t)(t + 2) * kstep; const char* b2 = last ? nB : cB + (size_t)(t + 2) * kstep;
            const char* a3 = a2 + kstep; const char* b3 = b2 + kstep;
            PG8_LDB(B0, 0, 0); PG8_LDB(B1, 0, 1); PG8_SCHED; PG8_LDA(At, 0, 0); PG8_STAGE(PG8_SA(1, 1), a1 + hstepA, voffA);
            PG8_WAIT_V(8); PG8_WAIT_L(0); PG8_BAR; PG8_MMA(0, 0, At, B0); PG8_MMA(0, 1, At, B1); PG8_BAR; PG8_SCHED;
            PG8_LDA(At, 0, 1); PG8_STAGE(PG8_SB(0, 0), b2, voffB); PG8_STAGE(PG8_SB(0, 1), b2 + hstepB, voffB); PG8_STAGE(PG8_SA(0, 0), a2, voffA);
            PG8_WAIT_V(8); PG8_WAIT_L(0); PG8_BAR; PG8_MMA(1, 0, At, B0); PG8_MMA(1, 1, At, B1); PG8_BAR; PG8_SCHED;
            PG8_LDB(B0, 1, 0); PG8_LDB(B1, 1, 1); PG8_SCHED; PG8_LDA(At, 1, 0); PG8_STAGE(PG8_SA(0, 1), a2 + hstepA, voffA);
            PG8_WAIT_V(8); PG8_WAIT_L(0); PG8_BAR; PG8_MMA(0, 0, At, B0); PG8_MMA(0, 1, At, B1); PG8_BAR; PG8_SCHED;
            PG8_LDA(At, 1, 1); PG8_STAGE(PG8_SB(1, 0), b3, voffB); PG8_STAGE(PG8_SB(1, 1), b3 + hstepB, voffB); PG8_STAGE(PG8_SA(1, 0), a3, voffA);
            PG8_WAIT_V(8); PG8_WAIT_L(0); PG8_BAR; PG8_MMA(1, 0, At, B0); PG8_MMA(1, 1, At, B1); PG8_BAR; PG8_SCHED;
        }
        if (wr == 0) PG8_BAR;
        E(acc, cur, wr, wc, fr, fq);
        if (!has_next) break;
#pragma unroll
        for (int a = 0; a < 2; ++a)
#pragma unroll
            for (int b = 0; b < 2; ++b)
#pragma unroll
                for (int m = 0; m < 4; ++m)
#pragma unroll
                    for (int n = 0; n < 2; ++n) acc[a][b][m][n] = (f32x4){0.f, 0.f, 0.f, 0.f};
        cur = nxt; cA = nA; cB = nB; ++ui;
        if (wr == 1) PG8_BAR;
    }
    PG8_WAIT_V(0);
    PG8_BAR;
#undef PG8_SA
#undef PG8_SB
#undef PG8_STAGE
#undef PG8_LDA
#undef PG8_LDB
#undef PG8_MMA
#undef PG8_WAIT_V
#undef PG8_WAIT_L
#undef PG8_BAR
#undef PG8_SCHED
}
}

#define LAS __attribute__((address_space(3)))
typedef unsigned short bf16;
typedef float f32x4 __attribute__((ext_vector_type(4)));
typedef float f32x16 __attribute__((ext_vector_type(16)));
typedef short bf16x8 __attribute__((ext_vector_type(8)));
typedef unsigned u32x4 __attribute__((ext_vector_type(4)));
typedef unsigned u32x2 __attribute__((ext_vector_type(2)));
using pg8::cvt_pk_bf16;
__device__ __forceinline__ float bf_lo(unsigned u) { return __uint_as_float(u << 16); }
__device__ __forceinline__ float bf_hi(unsigned u) { return __uint_as_float(u & 0xffff0000u); }
__device__ __forceinline__ float wave_sum(float v) {
#pragma unroll
    for (int o = 1; o < 64; o <<= 1) v += __shfl_xor(v, o);
    return v;
}

constexpr size_t MiB = 1u << 20;
constexpr size_t WS_WGU1 = 2 * MiB, WS_WD1 = 46 * MiB, WS_WGU2 = 68 * MiB, WS_WD2 = 112 * MiB, WS_WIN = 134 * MiB, WS_WQ = 147 * MiB + MiB / 2, WS_WK = 149 * MiB, WS_WV = 150 * MiB, WS_WOUT = 151 * MiB;
constexpr size_t WS_SS = 0;
constexpr size_t WS_XB2 = 632 * MiB;
constexpr size_t WS_XN = 160 * MiB;
constexpr size_t WS_Y = WS_XN;
constexpr size_t WS_H = 288 * MiB;
constexpr size_t WS_Z = 288 * MiB;
constexpr size_t WS_QRAW = 496 * MiB;
constexpr size_t WS_KRAW = 632 * MiB;
constexpr size_t WS_VT = 696 * MiB;
constexpr size_t WS_Q = 760 * MiB;
constexpr size_t WS_K = 856 * MiB;
constexpr size_t WS_END = 952 * MiB;
static_assert(WS_WGU1 + (size_t)NGU * DM * 2 <= WS_WD1 && WS_WD1 + (size_t)DM * DFF * 2 <= WS_WGU2 && WS_WGU2 + (size_t)NGU * DM * 2 <= WS_WD2 && WS_WD2 + (size_t)DM * DFF * 2 <= WS_WIN, "ws map 1");
static_assert(WS_WIN + (size_t)ZLD * DM * 2 <= WS_WQ && WS_WQ + (size_t)QW * 512 * 2 <= WS_WK && WS_WK + 1024 * 512 * 2 <= WS_WV && WS_WV + 1024 * 512 * 2 <= WS_WOUT && WS_WOUT + (size_t)DM * DM * 2 <= WS_XN, "ws map 2");
static_assert(WS_XN + (size_t)MTOK * DM * 2 <= WS_H && WS_H + (size_t)MTOK * DFF * 2 <= WS_KRAW && WS_Z + (size_t)MTOK * ZLD * 2 <= WS_QRAW && WS_QRAW + (size_t)MTOK * QW * 2 <= WS_KRAW, "ws map 3");
static_assert(WS_KRAW + (size_t)MTOK * 1024 * 2 <= WS_VT && WS_VT + (size_t)MTOK * 1024 * 2 <= WS_Q && WS_Q + (size_t)MTOK * QW * 2 <= WS_K && WS_K + (size_t)MTOK * QW * 2 <= WS_END, "ws map 4");

__device__ __forceinline__ unsigned f2bf(float f) { unsigned u = __builtin_bit_cast(unsigned, f); return (u + 0x7fffu + ((u >> 16) & 1u)) >> 16; }
__device__ __forceinline__ unsigned pk2(float lo, float hi) { return f2bf(lo) | (f2bf(hi) << 16); }
__device__ __forceinline__ void transpose_item(const float* W, int N, bf16* dst  , int K, int k0, int n0, LAS float* scr, int lane, const float* gk  ) {
    float wv[32];
#pragma unroll
    for (int i = 0; i < 32; ++i) { const int kk = 2 * i + (lane >> 5); wv[i] = W[(size_t)(k0 + kk) * N + n0 + (lane & 31)]; }
    if (gk) {
#pragma unroll
        for (int i = 0; i < 32; ++i) wv[i] *= gk[k0 + 2 * i + (lane >> 5)];
    }
#pragma unroll
    for (int i = 0; i < 32; ++i) { const int kk = 2 * i + (lane >> 5); scr[kk * 33 + (lane & 31)] = wv[i]; }
    asm volatile("s_waitcnt lgkmcnt(0)" ::: "memory");
    const int c = lane & 7;
#pragma unroll
    for (int j = 0; j < 4; ++j) { const int n = (lane >> 3) + 8 * j; const LAS float* s = scr + (8 * c) * 33 + n;
        u32x4 o; o.x = pk2(s[0 * 33], s[1 * 33]); o.y = pk2(s[2 * 33], s[3 * 33]); o.z = pk2(s[4 * 33], s[5 * 33]); o.w = pk2(s[6 * 33], s[7 * 33]);
        *(u32x4*)(dst + (size_t)n * K + k0 + 8 * c) = o; }
    asm volatile("s_waitcnt lgkmcnt(0)" ::: "memory");
}
__device__ __forceinline__ void rms_row_to_bf16(const float* xrow, const float* g, bf16* orow, int lane) {
    const f32x4* xr = (const f32x4*)xrow + lane; const f32x4* gr = (const f32x4*)g + lane;
    f32x4 v[8]; float s = 0.f;
#pragma unroll
    for (int j = 0; j < 8; ++j) { v[j] = xr[64 * j]; s += (v[j].x * v[j].x + v[j].y * v[j].y) + (v[j].z * v[j].z + v[j].w * v[j].w); }
    const float r = 1.0f / sqrtf(wave_sum(s) * (1.0f / DM) + EPS);
    u32x2* o8 = (u32x2*)orow + lane;
#pragma unroll
    for (int j = 0; j < 8; ++j) { const f32x4 gg = gr[64 * j]; u32x2 w; w.x = cvt_pk_bf16(v[j].x * r * gg.x, v[j].y * r * gg.y); w.y = cvt_pk_bf16(v[j].z * r * gg.z, v[j].w * r * gg.w); o8[64 * j] = w; }
}

__device__ __forceinline__ void p0_weights(LAS unsigned char* lds, unsigned char* ws, const float* wg1, const float* wu1, const float* wd1, const float* wg2, const float* wu2, const float* wd2,
                                           const float* win, const float* wq, const float* wkv, const float* wout, const float* g_mix, const float* g_ffn2, const float* g_q, const float* g_kv, int gw, int NGW, int wave, int lane) {
    LAS float* scr = (LAS float*)(lds + wave * 8448);
    constexpr int I_F = (DM / 64) * (DFF / 32);
    constexpr int I_IN = (DM / 64) * (3136 / 32), I_Q = (512 / 64) * (QW / 32), I_KV = (512 / 64) * (2048 / 32), I_O = (DM / 64) * (DM / 32);
    constexpr int NITEMS = 6 * I_F + I_IN + I_Q + I_KV + I_O;
    for (int it = gw; it < NITEMS; it += NGW) {
        int r = it;
        if (r < 6 * I_F) {
            const int which = r / I_F; r -= which * I_F; const int ffn = which / 3, kind = which % 3;
            if (kind < 2) { const float* W = wg1; if (which == 1) W = wu1; if (which == 3) W = wg2; if (which == 4) W = wu2; bf16* D = (bf16*)(ws + (ffn ? WS_WGU2 : WS_WGU1));
                const int nblk = DFF / 32, kb = r / nblk, nb = r % nblk, n0 = nb * 32; const int drow = (n0 / 128) * 256 + (n0 % 128) + kind * 128;
                transpose_item(W, DFF, D + (size_t)drow * DM, DM, kb * 64, n0, scr, lane, ffn ? g_ffn2 : nullptr); }
            else { const float* W = wd1; if (ffn) W = wd2; bf16* D = (bf16*)(ws + (ffn ? WS_WD2 : WS_WD1));
                const int nblk = DM / 32, kb = r / nblk, nb = r % nblk, n0 = nb * 32;
                transpose_item(W, DM, D + (size_t)n0 * DFF, DFF, kb * 64, n0, scr, lane, nullptr); }
            continue;
        }
        r -= 6 * I_F;
        if (r < I_IN) { const int nblk = 3136 / 32, kb = r / nblk, nb = r % nblk, n0 = nb * 32; transpose_item(win, 3136, (bf16*)(ws + WS_WIN) + (size_t)n0 * DM, DM, kb * 64, n0, scr, lane, g_mix); continue; }
        r -= I_IN;
        if (r < I_Q) { const int nblk = QW / 32, kb = r / nblk, nb = r % nblk, n0 = nb * 32; transpose_item(wq, QW, (bf16*)(ws + WS_WQ) + (size_t)n0 * 512, 512, kb * 64, n0, scr, lane, g_q); continue; }
        r -= I_Q;
        if (r < I_KV) { const int nblk = 2048 / 32, kb = r / nblk, nb = r % nblk, n0 = nb * 32; const int h = n0 >> 8, c = n0 & 255;
            bf16* D = (c < 128) ? (bf16*)(ws + WS_WK) + (size_t)(h * 128 + c) * 512 : (bf16*)(ws + WS_WV) + (size_t)(h * 128 + c - 128) * 512;
            transpose_item(wkv, 2048, D, 512, kb * 64, n0, scr, lane, g_kv); continue; }
        r -= I_KV;
        { const int nblk = DM / 32, kb = r / nblk, nb = r % nblk, n0 = nb * 32; transpose_item(wout, DM, (bf16*)(ws + WS_WOUT) + (size_t)n0 * DM, DM, kb * 64, n0, scr, lane, nullptr); }
    }
    { float* ssz = (float*)(ws + WS_SS); for (int i = gw * 64 + lane; i < 5 * MTOK; i += NGW * 64) ssz[i] = 0.f; }
    { u32x4* z = (u32x4*)((bf16*)(ws + WS_WIN) + (size_t)3136 * DM); const int n16 = (ZLD - 3136) * DM * 2 / 16;
      for (int i = gw * 64 + lane; i < n16; i += NGW * 64) z[i] = (u32x4){0u, 0u, 0u, 0u}; }
}

__device__ __forceinline__ void znorm_seg16(bf16* p, const float* g, float invn, int lane, int nvec  ) {
    u32x4 a[2]; float s = 0.f;
#pragma unroll
    for (int j = 0; j < 2; ++j) if (j < nvec) { a[j] = *(const u32x4*)(p + j * 512 + lane * 8);
#pragma unroll
        for (int k = 0; k < 4; ++k) { const float lo = bf_lo(a[j][k]), hi = bf_hi(a[j][k]); s += lo * lo + hi * hi; } }
    const float r = 1.0f / sqrtf(wave_sum(s) * invn + EPS);
#pragma unroll
    for (int j = 0; j < 2; ++j) if (j < nvec) { const f32x4 g0 = *(const f32x4*)(g + j * 512 + lane * 8), g1 = *(const f32x4*)(g + j * 512 + lane * 8 + 4); u32x4 w;
        w.x = cvt_pk_bf16(bf_lo(a[j].x) * r * g0.x, bf_hi(a[j].x) * r * g0.y); w.y = cvt_pk_bf16(bf_lo(a[j].y) * r * g0.z, bf_hi(a[j].y) * r * g0.w);
        w.z = cvt_pk_bf16(bf_lo(a[j].z) * r * g1.x, bf_hi(a[j].z) * r * g1.y); w.w = cvt_pk_bf16(bf_lo(a[j].w) * r * g1.z, bf_hi(a[j].w) * r * g1.w);
        *(u32x4*)(p + j * 512 + lane * 8) = w; }
}

__device__ const double ROPE_REV[32] = {0.15915494309189535, 0.11934937021124886, 0.08949940160889101, 0.06711508300522726, 0.050329212104487035, 0.03774158471741977, 0.0283021958306234, 0.02122365276477766,
    0.015915494309189534, 0.011934937021124886, 0.008949940160889102, 0.006711508300522725, 0.005032921210448704, 0.003774158471741977, 0.00283021958306234, 0.0021223652764777662,
    0.0015915494309189536, 0.0011934937021124885, 0.0008949940160889102, 0.0006711508300522726, 0.0005032921210448703, 0.00037741584717419774, 0.00028302195830623395, 0.0002122365276477766,
    0.00015915494309189535, 0.00011934937021124886, 8.949940160889102e-05, 6.711508300522725e-05, 5.0329212104487035e-05, 3.774158471741978e-05, 2.8302195830623396e-05, 2.122365276477766e-05};
constexpr float QSCALE = 0.07216878364870322f * 1.4426950408889634f;
__device__ __forceinline__ void qk_head(const bf16* nope, const bf16* rope, const float* g, bf16* dst, const float (&cs)[4], const float (&sn)[4], int j, float oscale) {
    const u32x4 a0 = *(const u32x4*)(nope + 16 * j), a1 = *(const u32x4*)(nope + 16 * j + 8);
    const u32x2 r1 = *(const u32x2*)(rope + 4 * j), r2 = *(const u32x2*)(rope + 32 + 4 * j);
    float x[16], y1[4], y2[4];
#pragma unroll
    for (int k = 0; k < 4; ++k) { x[2 * k] = bf_lo(a0[k]); x[2 * k + 1] = bf_hi(a0[k]); x[8 + 2 * k] = bf_lo(a1[k]); x[8 + 2 * k + 1] = bf_hi(a1[k]); }
    y1[0] = bf_lo(r1.x); y1[1] = bf_hi(r1.x); y1[2] = bf_lo(r1.y); y1[3] = bf_hi(r1.y);
    y2[0] = bf_lo(r2.x); y2[1] = bf_hi(r2.x); y2[2] = bf_lo(r2.y); y2[3] = bf_hi(r2.y);
    float s = 0.f;
#pragma unroll
    for (int k = 0; k < 16; ++k) s += x[k] * x[k];
#pragma unroll
    for (int k = 0; k < 4; ++k) s += y1[k] * y1[k] + y2[k] * y2[k];
    s += __shfl_xor(s, 1); s += __shfl_xor(s, 2); s += __shfl_xor(s, 4);
    const float r = 1.0f / sqrtf(s * (1.0f / QKD) + EPS);
    const f32x4 g0 = *(const f32x4*)(g + 16 * j), g1 = *(const f32x4*)(g + 16 * j + 4), g2 = *(const f32x4*)(g + 16 * j + 8), g3 = *(const f32x4*)(g + 16 * j + 12);
    const f32x4 ga = *(const f32x4*)(g + 128 + 4 * j), gb = *(const f32x4*)(g + 160 + 4 * j);
    const float ro = r * oscale;
    u32x4 w0, w1;
    w0.x = cvt_pk_bf16(x[0] * ro * g0.x, x[1] * ro * g0.y); w0.y = cvt_pk_bf16(x[2] * ro * g0.z, x[3] * ro * g0.w); w0.z = cvt_pk_bf16(x[4] * ro * g1.x, x[5] * ro * g1.y); w0.w = cvt_pk_bf16(x[6] * ro * g1.z, x[7] * ro * g1.w);
    w1.x = cvt_pk_bf16(x[8] * ro * g2.x, x[9] * ro * g2.y); w1.y = cvt_pk_bf16(x[10] * ro * g2.z, x[11] * ro * g2.w); w1.z = cvt_pk_bf16(x[12] * ro * g3.x, x[13] * ro * g3.y); w1.w = cvt_pk_bf16(x[14] * ro * g3.z, x[15] * ro * g3.w);
    *(u32x4*)(dst + 16 * j) = w0; *(u32x4*)(dst + 16 * j + 8) = w1;
    float o1[4], o2[4];
#pragma unroll
    for (int k = 0; k < 4; ++k) { const float a = y1[k] * r * ga[k], b = y2[k] * r * gb[k]; o1[k] = (a * cs[k] - b * sn[k]) * oscale; o2[k] = (b * cs[k] + a * sn[k]) * oscale; }
    u32x2 v1, v2; v1.x = cvt_pk_bf16(o1[0], o1[1]); v1.y = cvt_pk_bf16(o1[2], o1[3]); v2.x = cvt_pk_bf16(o2[0], o2[1]); v2.y = cvt_pk_bf16(o2[2], o2[3]);
    *(u32x2*)(dst + 128 + 4 * j) = v1; *(u32x2*)(dst + 160 + 4 * j) = v2;
}
__device__ __forceinline__ void qk_token(int tok, const int* positions, const bf16* Qraw, const bf16* Kraw, const bf16* Z, const float* qg, const float* kg, bf16* Q, bf16* K, int lane) {
    const int h = lane >> 3, j = lane & 7; const int pos = positions[tok];
    float cs[4], sn[4];
#pragma unroll
    for (int k = 0; k < 4; ++k) { const double rev = (double)pos * ROPE_REV[4 * j + k]; const float fr = (float)(rev - __builtin_floor(rev)); cs[k] = __builtin_amdgcn_cosf(fr); sn[k] = __builtin_amdgcn_sinf(fr); }
    qk_head(Qraw + (size_t)tok * QW + h * QKD, Qraw + (size_t)tok * QW + h * QKD + 128, qg, Q + (size_t)tok * QW + h * QKD, cs, sn, j, QSCALE);
    qk_head(Kraw + (size_t)tok * 1024 + h * 128, Z + (size_t)tok * ZLD + 3072, kg, K + (size_t)tok * QW + h * QKD, cs, sn, j, 1.0f);
}

namespace att {
constexpr int KP = 400, VP = 144, KBYTES = 64 * KP, VBYTES = 128 * VP, STAGE = KBYTES + VBYTES;
#define MFMA32(a, b, c) __builtin_amdgcn_mfma_f32_32x32x16_bf16((a), (b), (c), 0, 0, 0)
__device__ __forceinline__ void attn_unit(LAS unsigned char* lds, const bf16* Q, const bf16* K, const bf16* Vt, bf16* Y, const float* gout, int b, int h, int qb, const int tid) {
    const int lane = tid & 63, r32 = lane & 31, hi = lane >> 5; const int wid = __builtin_amdgcn_readfirstlane(tid >> 6);
    const int q0 = qb * 256, qrow = q0 + wid * 32 + r32;
    const size_t tok0 = (size_t)b * SEQ;
    bf16x8 qf[12];
    { const bf16* qp = Q + (tok0 + qrow) * QW + h * QKD + hi * 8;
#pragma unroll
      for (int dk = 0; dk < 12; ++dk) qf[dk] = *(const bf16x8*)(qp + dk * 16); }
    const bf16* ksrc = K + (tok0 + (tid >> 3)) * QW + h * QKD + (tid & 7) * 8;
    const unsigned kdst = (tid >> 3) * KP + (tid & 7) * 16;
    const bf16* vsrc = Vt + (size_t)(h * VD + (tid >> 2)) * MTOK + tok0 + (tid & 3) * 8;
    const unsigned vdst = KBYTES + (tid >> 2) * VP + (tid & 3) * 16;
    const int NT = 4 * (qb + 1), my_last = 4 * qb + (wid >> 1);
    u32x4 kr[3], vr[2];
#pragma unroll
    for (int i = 0; i < 3; ++i) kr[i] = *(const u32x4*)(ksrc + i * 64);
#pragma unroll
    for (int i = 0; i < 2; ++i) vr[i] = *(const u32x4*)(vsrc + i * 32);
    __syncthreads();
#pragma unroll
    for (int i = 0; i < 3; ++i) *(LAS u32x4*)(lds + kdst + i * 128) = kr[i];
#pragma unroll
    for (int i = 0; i < 2; ++i) *(LAS u32x4*)(lds + vdst + i * 64) = vr[i];
    __syncthreads();
    const int pim = (r32 & 16) + ((r32 >> 2) & 1) * 8 + ((r32 >> 3) & 1) * 4 + (r32 & 3);
    const unsigned koff = pim * KP + hi * 16, voff = KBYTES + r32 * VP + hi * 16;
    f32x16 o[4];
#pragma unroll
    for (int d = 0; d < 4; ++d)
#pragma unroll
        for (int r = 0; r < 16; ++r) o[d][r] = 0.f;
    float m_run = -1e30f, l_run = 0.f;
    for (int t = 0; t < NT; ++t) {
        const unsigned bo = (t & 1) * STAGE;
        const bool more = (t + 1 < NT);
        if (more) {
#pragma unroll
            for (int i = 0; i < 3; ++i) kr[i] = *(const u32x4*)(ksrc + (size_t)(t + 1) * 64 * QW + i * 64);
#pragma unroll
            for (int i = 0; i < 2; ++i) vr[i] = *(const u32x4*)(vsrc + (t + 1) * 64 + i * 32);
        }
        if (t <= my_last) {
            f32x16 s0, s1;
#pragma unroll
            for (int r = 0; r < 16; ++r) { s0[r] = 0.f; s1[r] = 0.f; }
#pragma unroll
            for (int dk = 0; dk < 12; ++dk) {
                const bf16x8 k0 = *(const LAS bf16x8*)(lds + bo + koff + dk * 32), k1 = *(const LAS bf16x8*)(lds + bo + koff + 32 * KP + dk * 32);
                s0 = MFMA32(k0, qf[dk], s0); s1 = MFMA32(k1, qf[dk], s1);
            }
            if (t >= 4 * qb) {
                const int kb0 = 64 * t + 8 * hi;
#pragma unroll
                for (int r = 0; r < 16; ++r) { const int key = kb0 + 16 * (r >> 3) + (r & 7); if (key > qrow) s0[r] = -1e30f; if (key + 32 > qrow) s1[r] = -1e30f; }
            }
            float mx = s0[0];
#pragma unroll
            for (int r = 1; r < 16; ++r) mx = fmaxf(mx, s0[r]);
#pragma unroll
            for (int r = 0; r < 16; ++r) mx = fmaxf(mx, s1[r]);
            mx = fmaxf(mx, __shfl_xor(mx, 32));
            const float m_new = fmaxf(m_run, mx), alpha = __builtin_amdgcn_exp2f(m_run - m_new);
            m_run = m_new;
            float ls = 0.f;
#pragma unroll
            for (int r = 0; r < 16; ++r) { s0[r] = __builtin_amdgcn_exp2f(s0[r] - m_new); s1[r] = __builtin_amdgcn_exp2f(s1[r] - m_new); ls += s0[r] + s1[r]; }
            l_run = l_run * alpha + ls;
#pragma unroll
            for (int d = 0; d < 4; ++d)
#pragma unroll
                for (int r = 0; r < 16; ++r) o[d][r] *= alpha;
            u32x4 pw[4];
#pragma unroll
            for (int c = 0; c < 2; ++c) {
                pw[c] = (u32x4){cvt_pk_bf16(s0[8 * c], s0[8 * c + 1]), cvt_pk_bf16(s0[8 * c + 2], s0[8 * c + 3]), cvt_pk_bf16(s0[8 * c + 4], s0[8 * c + 5]), cvt_pk_bf16(s0[8 * c + 6], s0[8 * c + 7])};
                pw[2 + c] = (u32x4){cvt_pk_bf16(s1[8 * c], s1[8 * c + 1]), cvt_pk_bf16(s1[8 * c + 2], s1[8 * c + 3]), cvt_pk_bf16(s1[8 * c + 4], s1[8 * c + 5]), cvt_pk_bf16(s1[8 * c + 6], s1[8 * c + 7])};
            }
#pragma unroll
            for (int kc = 0; kc < 4; ++kc) {
                const bf16x8 pf = __builtin_bit_cast(bf16x8, pw[kc]);
#pragma unroll
                for (int d = 0; d < 4; ++d) { const bf16x8 vf = *(const LAS bf16x8*)(lds + bo + voff + d * 32 * VP + kc * 32); o[d] = MFMA32(vf, pf, o[d]); }
            }
        }
        if (more) {
            const unsigned nb = ((t + 1) & 1) * STAGE;
#pragma unroll
            for (int i = 0; i < 3; ++i) *(LAS u32x4*)(lds + nb + kdst + i * 128) = kr[i];
#pragma unroll
            for (int i = 0; i < 2; ++i) *(LAS u32x4*)(lds + nb + vdst + i * 64) = vr[i];
        }
        __syncthreads();
    }
    const float l = l_run + __shfl_xor(l_run, 32), inv = 1.0f / l;
    float ss = 0.f;
#pragma unroll
    for (int d = 0; d < 4; ++d)
#pragma unroll
        for (int r = 0; r < 16; ++r) { o[d][r] *= inv; ss += o[d][r] * o[d][r]; }
    ss += __shfl_xor(ss, 32);
    const float rn = 1.0f / sqrtf(ss * (1.0f / VD) + EPS);
    bf16* yp = Y + (tok0 + qrow) * DM + 1024 + h * VD + 4 * hi; const float* gp = gout + h * VD + 4 * hi;
#pragma unroll
    for (int d = 0; d < 4; ++d)
#pragma unroll
        for (int r4 = 0; r4 < 4; ++r4) { const f32x4 g = *(const f32x4*)(gp + 32 * d + 8 * r4); u32x2 w;
            w.x = cvt_pk_bf16(o[d][4 * r4] * rn * g.x, o[d][4 * r4 + 1] * rn * g.y); w.y = cvt_pk_bf16(o[d][4 * r4 + 2] * rn * g.z, o[d][4 * r4 + 3] * rn * g.w);
            *(u32x2*)(yp + 32 * d + 8 * r4) = w; }
}
}

namespace gm {
constexpr int WP = 272;
constexpr int WBYTES = 128 * WP;
__device__ __forceinline__ void gmlp_phase(LAS unsigned char* lds, const bf16* Z, const float* w_s, const float* b_s, const float* gout, const float* ssv, const float* gv, bf16* Y, int vcu, int G, const int tid) {
    const int lane = tid & 63, l16 = lane & 15, q4 = lane >> 4; const int wid = __builtin_amdgcn_readfirstlane(tid >> 6);
    int gcur = -1;
    for (int un = vcu; un < 2048; un += G) {
        const int g = un & 7, bc = un >> 3;
        const size_t tok0 = (size_t)bc * 128;
        __syncthreads();
        if (g != gcur) {
            gcur = g;
#pragma unroll
            for (int i = 0; i < 8; ++i) { const int p = tid + 512 * i, t = p >> 5, s = (p & 31) * 4; const f32x4 w = *(const f32x4*)(w_s + (size_t)g * 16384 + t * 128 + s);
                u32x2 o; o.x = cvt_pk_bf16(s <= t ? w.x : 0.f, s + 1 <= t ? w.y : 0.f); o.y = cvt_pk_bf16(s + 2 <= t ? w.z : 0.f, s + 3 <= t ? w.w : 0.f);
                *(LAS u32x2*)(lds + t * WP + s * 2) = o; }
        }
#pragma unroll
        for (int i = 0; i < 4; ++i) { const int p = tid + 512 * i, s = p >> 4, seg = p & 15; const u32x4 v = *(const u32x4*)(Z + (tok0 + s) * ZLD + 1024 + g * 128 + seg * 8);
            const float rv = __builtin_amdgcn_rsqf(ssv[tok0 + s] * (1.0f / 1024.0f) + EPS); const f32x4 g0 = *(const f32x4*)(gv + g * 128 + seg * 8), g1 = *(const f32x4*)(gv + g * 128 + seg * 8 + 4);
            LAS unsigned short* dst = (LAS unsigned short*)(lds + WBYTES + (seg * 8) * WP + s * 2);
            const unsigned w0 = cvt_pk_bf16(bf_lo(v.x) * rv * g0.x, bf_hi(v.x) * rv * g0.y), w1 = cvt_pk_bf16(bf_lo(v.y) * rv * g0.z, bf_hi(v.y) * rv * g0.w);
            const unsigned w2 = cvt_pk_bf16(bf_lo(v.z) * rv * g1.x, bf_hi(v.z) * rv * g1.y), w3 = cvt_pk_bf16(bf_lo(v.w) * rv * g1.z, bf_hi(v.w) * rv * g1.w);
            dst[0 * (WP / 2)] = (unsigned short)(w0 & 0xffffu); dst[1 * (WP / 2)] = (unsigned short)(w0 >> 16); dst[2 * (WP / 2)] = (unsigned short)(w1 & 0xffffu); dst[3 * (WP / 2)] = (unsigned short)(w1 >> 16);
            dst[4 * (WP / 2)] = (unsigned short)(w2 & 0xffffu); dst[5 * (WP / 2)] = (unsigned short)(w2 >> 16); dst[6 * (WP / 2)] = (unsigned short)(w3 & 0xffffu); dst[7 * (WP / 2)] = (unsigned short)(w3 >> 16); }
        __syncthreads();
        pg8::f32x4 acc[8];
#pragma unroll
        for (int d = 0; d < 8; ++d) acc[d] = (pg8::f32x4){0.f, 0.f, 0.f, 0.f};
        const int nsb = (wid >> 1) + 1;
        for (int sb = 0; sb < nsb; ++sb) {
            const bf16x8 wf = *(const LAS bf16x8*)(lds + (16 * wid + l16) * WP + sb * 64 + q4 * 16);
#pragma unroll
            for (int d = 0; d < 8; ++d) { const bf16x8 vf = *(const LAS bf16x8*)(lds + WBYTES + (16 * d + l16) * WP + sb * 64 + q4 * 16); acc[d] = __builtin_amdgcn_mfma_f32_16x16x32_bf16(vf, wf, acc[d], 0, 0, 0); }
        }
        const int t = 16 * wid + l16; const float bs = b_s[g * 128 + t];
        const bf16* up = Z + (tok0 + t) * ZLD + g * 128 + 4 * q4;
        float ss = 0.f;
#pragma unroll
        for (int d = 0; d < 8; ++d) { const u32x2 uu = *(const u32x2*)(up + 16 * d);
            acc[d][0] = bf_lo(uu.x) * (acc[d][0] + bs); acc[d][1] = bf_hi(uu.x) * (acc[d][1] + bs); acc[d][2] = bf_lo(uu.y) * (acc[d][2] + bs); acc[d][3] = bf_hi(uu.y) * (acc[d][3] + bs);
            ss += (acc[d][0] * acc[d][0] + acc[d][1] * acc[d][1]) + (acc[d][2] * acc[d][2] + acc[d][3] * acc[d][3]); }
        ss += __shfl_xor(ss, 16); ss += __shfl_xor(ss, 32);
        const float rn = 1.0f / sqrtf(ss * (1.0f / 128.0f) + EPS);
        bf16* yp = Y + (tok0 + t) * DM + g * 128 + 4 * q4; const float* gp = gout + g * 128 + 4 * q4;
#pragma unroll
        for (int d = 0; d < 8; ++d) { const f32x4 gg = *(const f32x4*)(gp + 16 * d); u32x2 w; w.x = cvt_pk_bf16(acc[d][0] * rn * gg.x, acc[d][1] * rn * gg.y); w.y = cvt_pk_bf16(acc[d][2] * rn * gg.z, acc[d][3] * rn * gg.w);
            *(u32x2*)(yp + 16 * d) = w; }
    }
}
}

constexpr int LDS_BYTES = 147456;
constexpr int NPHASE = 10;
#ifndef DUP_MASK
#define DUP_MASK 0
#endif
struct Args { const float* in[24]; float* out; unsigned char* ws; int ph_lo, ph_hi; };

__global__ void __launch_bounds__(512, 2) fwd_megakernel(Args a) {
    extern __shared__ __attribute__((aligned(16))) unsigned char lds_raw[];
    LAS unsigned char* lds = (LAS unsigned char*)lds_raw;
    cg::grid_group grid = cg::this_grid();
    const int G = gridDim.x, bx = blockIdx.x; const int vcu = (G % 8 == 0) ? (bx % 8) * (G / 8) + bx / 8 : bx;
    const int NGW = G * 8;
    for (int ph = a.ph_lo; ph < a.ph_hi; ++ph) {
    int rep = 0;
phase_again:
    int tid = threadIdx.x; asm volatile("" : "+v"(tid));
    unsigned char* ws = a.ws; asm volatile("" : "+s"(ws)); float* out = a.out; asm volatile("" : "+s"(out));
    const int lane = tid & 63, wave = __builtin_amdgcn_readfirstlane(tid >> 6), gw = vcu * 8 + wave;
    bf16* XN = (bf16*)(ws + WS_XN); bf16* Yb = (bf16*)(ws + WS_Y); bf16* H = (bf16*)(ws + WS_H); bf16* Z = (bf16*)(ws + WS_Z);
    bf16* QRAW = (bf16*)(ws + WS_QRAW); bf16* KRAW = (bf16*)(ws + WS_KRAW); bf16* VT = (bf16*)(ws + WS_VT); bf16* Qb = (bf16*)(ws + WS_Q); bf16* Kb = (bf16*)(ws + WS_K);
        const bool is_gemm = (ph == 1 || ph == 2 || ph == 3 || ph == 4 || ph == 7 || ph == 8 || ph == 9);
        float* SS = (float*)(ws + WS_SS); bf16* XB1 = (bf16*)out;
        if (is_gemm) {
            const int nsub = (ph == 4) ? 3 : 1;
            for (int sub = 0; sub < nsub; ++sub) {
                pg8::Gemm g; pg8::Epi E; E.mode = 0; E.O = nullptr; E.ldc = 0; E.base = nullptr; E.base_bf = nullptr; E.out = nullptr; E.alpha = 0.f; E.rs = nullptr; E.rs_invn = 1.0f / DM; E.xb = nullptr; E.ss_out = nullptr;
                if (ph == 1) { g = pg8::Gemm{XN, (const bf16*)(ws + WS_WGU1), MTOK, NGU, DM, DM, DM}; E.mode = 2; E.O = H; E.ldc = DFF; }
                else if (ph == 8) { g = pg8::Gemm{(const bf16*)(ws + WS_XB2), (const bf16*)(ws + WS_WGU2), MTOK, NGU, DM, DM, DM}; E.mode = 2; E.O = H; E.ldc = DFF; E.rs = SS + MTOK; }
                else if (ph == 2) { g = pg8::Gemm{H, (const bf16*)(ws + WS_WD1), MTOK, DM, DFF, DFF, DFF}; E.mode = 3; E.base = a.in[0]; E.ldc = DM; E.alpha = 0.5f; E.xb = XB1; E.ss_out = SS; }
                else if (ph == 9) { g = pg8::Gemm{H, (const bf16*)(ws + WS_WD2), MTOK, DM, DFF, DFF, DFF}; E.mode = 3; E.base_bf = (const bf16*)(ws + WS_XB2); E.out = out; E.ldc = DM; E.alpha = 0.5f; }
                else if (ph == 3) { g = pg8::Gemm{XB1, (const bf16*)(ws + WS_WIN), MTOK, ZLD, DM, DM, DM}; E.mode = 1; E.O = Z; E.ldc = ZLD; E.rs = SS; E.ss_out = SS + 2 * MTOK; }
                else if (ph == 7) { g = pg8::Gemm{Yb, (const bf16*)(ws + WS_WOUT), MTOK, DM, DM, DM, DM}; E.mode = 3; E.base_bf = XB1; E.ldc = DM; E.alpha = 1.0f; E.xb = (bf16*)(ws + WS_XB2); E.ss_out = SS + MTOK; }
                else if (sub == 0) { g = pg8::Gemm{Z + 2048, (const bf16*)(ws + WS_WQ), MTOK, QW, 512, ZLD, 512}; E.O = QRAW; E.ldc = QW; E.rs = SS + 3 * MTOK; E.rs_invn = 1.0f / 512.0f; }
                else if (sub == 1) { g = pg8::Gemm{Z + 2560, (const bf16*)(ws + WS_WK), MTOK, 1024, 512, ZLD, 512}; E.O = KRAW; E.ldc = 1024; E.rs = SS + 4 * MTOK; E.rs_invn = 1.0f / 512.0f; }
                else { g = pg8::Gemm{(const bf16*)(ws + WS_WV), Z + 2560, 1024, MTOK, 512, 512, ZLD}; E.mode = 4; E.O = VT; E.ldc = MTOK; E.rs = SS + 4 * MTOK; E.rs_invn = 1.0f / 512.0f; }
                pg8::StaticOrder S; S.init(g.M, g.N, G, bx, (ph == 2 || ph == 7 || ph == 9) ? 4 : 8);
#ifndef NO_GEMM
                pg8::gemm_phase(lds, g, S, E, tid);
#endif
            }
#ifndef NO_GM
            if (ph == 4) gm::gmlp_phase(lds, Z, a.in[9], a.in[10], a.in[17], SS + 2 * MTOK, a.in[8], Yb, vcu, G, tid);
#endif
        } else if (ph == 0) {
            p0_weights(lds, ws, a.in[3], a.in[4], a.in[5], a.in[21], a.in[22], a.in[23], a.in[7], a.in[12], a.in[14], a.in[19], a.in[6], a.in[20], a.in[11], a.in[13], gw, NGW, wave, lane);
            for (int m = gw; m < MTOK; m += NGW) rms_row_to_bf16(a.in[0] + (size_t)m * DM, a.in[2], XN + (size_t)m * DM, lane);
        } else if (ph == 5) {
            for (int m = gw; m < MTOK; m += NGW) qk_token(m, (const int*)a.in[1], QRAW, KRAW, Z, a.in[15], a.in[16], Qb, Kb, lane);
        } else if (ph == 6) {
            for (int v = vcu; v < 256; v += G) { const int bh = v >> 1, s0 = (v & 1) * 2;
#pragma unroll 1
                for (int i = 0; i < 4; ++i) { const int qb = (i == 0) ? 7 - s0 : (i == 1) ? s0 : (i == 2) ? 6 - s0 : s0 + 1;
#ifndef NO_ATT
                    att::attn_unit(lds, Qb, Kb, VT, Yb, a.in[18], bh >> 3, bh & 7, qb, tid);
#endif
                } }
        }
        if (ph + 1 < a.ph_hi) grid.sync();
#if DUP_MASK
        if (((DUP_MASK >> ph) & 1) && rep == 0) { rep = 1; if (ph + 1 >= a.ph_hi) grid.sync(); goto phase_again; }
#endif
    }
}

extern "C" void kernel_launch(void* const* d_in, const int* in_sizes, int n_in, void* d_out, int out_size, void* d_ws, size_t ws_size, hipStream_t stream) {
    static int grid = 0;
    if (grid == 0) {
        if (n_in != 24 || out_size != MTOK * DM || ws_size < WS_END) { fprintf(stderr, "kernel_launch: unexpected problem (n_in %d, out %d, ws %zu); nothing launched\n", n_in, out_size, ws_size); grid = -1; return; }
        int dev = 0, cus = 0, per_cu = 0;
        if (hipGetDevice(&dev) != hipSuccess || hipDeviceGetAttribute(&cus, hipDeviceAttributeMultiprocessorCount, dev) != hipSuccess) { grid = -1; return; }
        if (hipFuncSetAttribute((const void*)fwd_megakernel, hipFuncAttributeMaxDynamicSharedMemorySize, LDS_BYTES) != hipSuccess) { fprintf(stderr, "kernel_launch: hipFuncSetAttribute failed\n"); grid = -1; return; }
        if (hipOccupancyMaxActiveBlocksPerMultiprocessor(&per_cu, (const void*)fwd_megakernel, 512, LDS_BYTES) != hipSuccess || per_cu < 1) { fprintf(stderr, "kernel_launch: occupancy query says %d\n", per_cu); per_cu = 1; }
        (void)hipGetLastError();
        grid = cus * per_cu;
        if (grid % 8 != 0 || grid > 2048) grid = cus;
    }
    if (grid < 0) return;
    Args a{};
    for (int i = 0; i < 24; ++i) a.in[i] = (const float*)d_in[i];
    a.out = (float*)d_out; a.ws = (unsigned char*)d_ws;
#if MK_MULTI
    for (int ph = 0; ph < NPHASE; ++ph) { a.ph_lo = ph; a.ph_hi = ph + 1; hipLaunchKernelGGL(fwd_megakernel, dim3(grid), dim3(512), LDS_BYTES, stream, a); }
#else
    a.ph_lo = 0; a.ph_hi = NPHASE;
    void* args[] = {&a};
    hipError_t e = hipLaunchCooperativeKernel((const void*)fwd_megakernel, dim3(grid), dim3(512), args, LDS_BYTES, stream);
    if (e != hipSuccess) fprintf(stderr, "kernel_launch: cooperative launch failed: %s (grid %d)\n", hipGetErrorString(e), grid);
#endif
}
```

```cpp
#include <hip/hip_runtime.h>
#include <hip/hip_cooperative_groups.h>
#include <cstdio>
#include <cstdint>
#include <cstddef>
namespace cg = cooperative_groups;

#ifndef MK_MULTI
#define MK_MULTI 0
#endif

constexpr int BATCH = 16, SEQ = 2048, DM = 2048, MTOK = BATCH * SEQ, DFF = 5504, NGU = 2 * DFF;
constexpr int ZLD = 3328;
constexpr int NH = 8, QKD = 192, VD = 128, QW = NH * QKD  ;
constexpr float EPS = 1e-6f;

namespace pg8 {
#define PG8_LAS __attribute__((address_space(3)))
typedef unsigned short bf16_t;
typedef short bf16x8 __attribute__((ext_vector_type(8)));
typedef float f32x4 __attribute__((ext_vector_type(4)));
typedef float f32x2 __attribute__((ext_vector_type(2)));
typedef unsigned u32x4 __attribute__((ext_vector_type(4)));
typedef unsigned u32x2 __attribute__((ext_vector_type(2)));
typedef __bf16 bf16x2_t __attribute__((ext_vector_type(2)));
constexpr int BM = 256, BK = 64, HALF = 128, HTB = HALF * BK * 2  , STAGE_BYTES = 8 * HTB, NXCD = 8, WGM = 8;

__host__ __device__ __forceinline__ int lds_byte(int r, int c) { const int st = (r >> 4) * 2 + (c >> 5), rr = r & 15, cc = c & 31, ob = rr * 64 + cc * 2; return st * 1024 + (ob ^ (((ob >> 9) & 1) << 5)); }
__host__ __device__ __forceinline__ void stage_rc(int b, int& R, int& C) { const int st = b / 1024, sb = b % 1024, swz = sb ^ (((sb >> 9) & 1) << 5); R = (st >> 1) * 16 + swz / 64; C = (st & 1) * 32 + (swz % 64) / 2; }
__host__ __device__ __forceinline__ int perm32(int rho) { const int n = rho >> 4, i = rho & 15; return 8 * (i >> 2) + 4 * n + (i & 3); }

struct Unit { int pm, pn; };
struct Gemm { const bf16_t* A; const bf16_t* Bt; int M, N, K, lda, ldb; };

struct StaticOrder {
    int nM, nN, nwg, G, c, wgm;
    __host__ __device__ void init(int M, int N, int G_, int c_, int wgm_) { nM = M / BM; nN = N / BM; nwg = nM * nN; G = G_; c = c_; wgm = wgm_; }
    __host__ __device__ bool next(int i, Unit& u) const {
        const long L = (long)i * G + c; if (L >= nwg) return false;
        int wgid = (int)L; { const int q = nwg / NXCD, r = nwg % NXCD, xcd = wgid % NXCD, off = wgid / NXCD; wgid = (xcd < r ? xcd * (q + 1) : r * (q + 1) + (xcd - r) * q) + off; }
        const int nig = wgm * nN, gid = wgid / nig, fm = gid * wgm, gsz = (nM - fm) < wgm ? (nM - fm) : wgm;
        u.pm = fm + ((wgid % nig) % gsz); u.pn = (wgid % nig) / gsz; return true;
    }
};

__device__ __forceinline__ unsigned cvt_pk_bf16(float lo, float hi) { f32x2 v = {lo, hi}; bf16x2_t b = __builtin_convertvector(v, bf16x2_t); return __builtin_bit_cast(unsigned, b); }
__device__ __forceinline__ f32x2 gelu_pk(f32x2 v) {
    const f32x2 av = __builtin_elementwise_abs(v), d = av * 0.2316418882f + 1.0f;
    f32x2 t; t.x = __builtin_amdgcn_rcpf(d.x); t.y = __builtin_amdgcn_rcpf(d.y);
    f32x2 q = t * 0.5307027145f + (-0.7265760135f); q = q * t + 0.7107068705f; q = q * t + (-0.142248368f); q = q * t + 0.127414796f; q = q * t;
    const f32x2 s = (v * v) * (-0.72134752044f);
    f32x2 e; e.x = __builtin_amdgcn_exp2f(s.x); e.y = __builtin_amdgcn_exp2f(s.y);
    const f32x2 m = v * (q * e), r = v - m;
    f32x2 o; o.x = v.x < 0.f ? m.x : r.x; o.y = v.y < 0.f ? m.y : r.y; return o;
}
__device__ __forceinline__ f32x4 gelu4(f32x4 v) { f32x2 a = gelu_pk((f32x2){v[0], v[1]}), b = gelu_pk((f32x2){v[2], v[3]}); return (f32x4){a.x, a.y, b.x, b.y}; }
__device__ __forceinline__ float silu_mul(float g, float u) { return g * u * __builtin_amdgcn_rcpf(1.0f + __builtin_amdgcn_exp2f(-1.4426950408889634f * g)); }

struct Epi {
    int mode; bf16_t* O; int ldc; const float* base; const bf16_t* base_bf; float* out; float alpha; const float* rs; float rs_invn; bf16_t* xb; float* ss_out;
    __device__ __forceinline__ void operator()(const f32x4 (&acc)[2][2][4][2], const Unit& u, int wr, int wc, int fr, int fq) const {
        const int row0 = u.pm * BM + wr * 64 + fr;
#ifdef FORCE_MODE
        const int mode = FORCE_MODE;
#endif
        if (mode == 3) {
            const int col0 = u.pn * BM + wc * 32 + 8 * fq;
#pragma unroll
            for (int ai = 0; ai < 2; ++ai)
#pragma unroll
                for (int m = 0; m < 4; ++m) { const int row = row0 + ai * HALF + m * 16; const size_t off = (size_t)row * ldc + col0; float ssr = 0.f;
#pragma unroll
                    for (int bj = 0; bj < 2; ++bj) { f32x4 b0, b1;
                        if (base_bf) { const u32x4 t = *(const u32x4*)(base_bf + off + bj * HALF);
                            b0 = (f32x4){__uint_as_float(t.x << 16), __uint_as_float(t.x & 0xffff0000u), __uint_as_float(t.y << 16), __uint_as_float(t.y & 0xffff0000u)};
                            b1 = (f32x4){__uint_as_float(t.z << 16), __uint_as_float(t.z & 0xffff0000u), __uint_as_float(t.w << 16), __uint_as_float(t.w & 0xffff0000u)}; }
                        else { b0 = *(const f32x4*)(base + off + bj * HALF); b1 = *(const f32x4*)(base + off + bj * HALF + 4); }
                        const f32x4 o0 = b0 + acc[ai][bj][m][0] * alpha, o1 = b1 + acc[ai][bj][m][1] * alpha;
                        if (out) { *(f32x4*)(out + off + bj * HALF) = o0; *(f32x4*)(out + off + bj * HALF + 4) = o1; }
                        if (xb) { ssr += (o0[0] * o0[0] + o0[1] * o0[1]) + (o0[2] * o0[2] + o0[3] * o0[3]) + (o1[0] * o1[0] + o1[1] * o1[1]) + (o1[2] * o1[2] + o1[3] * o1[3]);
                            u32x4 w; w.x = cvt_pk_bf16(o0[0], o0[1]); w.y = cvt_pk_bf16(o0[2], o0[3]); w.z = cvt_pk_bf16(o1[0], o1[1]); w.w = cvt_pk_bf16(o1[2], o1[3]); *(u32x4*)(xb + off + bj * HALF) = w; } }
                    if (xb) { ssr += __shfl_xor(ssr, 16); ssr += __shfl_xor(ssr, 32); if (fq == 0) atomicAdd(ss_out + row, ssr); }
                    if (m == 3) asm volatile("" ::: "memory"); }
            return;
        }
        f32x4 cs[2][2];
#pragma unroll
        for (int bj = 0; bj < 2; ++bj)
#pragma unroll
            for (int n = 0; n < 2; ++n) cs[bj][n] = (f32x4){1.f, 1.f, 1.f, 1.f};
        if (mode == 4) {
            const int c0 = u.pn * BM + wc * 32 + 8 * fq;
#pragma unroll
            for (int bj = 0; bj < 2; ++bj)
#pragma unroll
                for (int n = 0; n < 2; ++n) { const f32x4 s = *(const f32x4*)(rs + c0 + bj * HALF + 4 * n);
#pragma unroll
                    for (int i = 0; i < 4; ++i) cs[bj][n][i] = __builtin_amdgcn_rsqf(s[i] * rs_invn + 1e-6f); }
        }
        const bool rowscale = (rs != nullptr) && (mode != 4);
        const bool act = (mode == 1) && (u.pn < 8), stat = (mode == 1) && (u.pn >= 4) && (u.pn < 12);
        float* ssp = ss_out + (u.pn < 8 ? 0 : (u.pn < 10 ? 32768 : 65536));
        const int col0 = (mode == 2 ? u.pn * HALF : u.pn * BM) + wc * 32 + 8 * fq;
#pragma unroll
        for (int ai = 0; ai < 2; ++ai)
#pragma unroll
            for (int m = 0; m < 4; ++m) { const int row = row0 + ai * HALF + m * 16; bf16_t* rowp = O + (size_t)row * ldc + col0;
                float r = 1.0f; if (rowscale) r = __builtin_amdgcn_rsqf(rs[row] * rs_invn + 1e-6f);
                if (mode == 2) {
                    const f32x4 g0 = acc[ai][0][m][0] * r, g1 = acc[ai][0][m][1] * r, u0 = acc[ai][1][m][0] * r, u1 = acc[ai][1][m][1] * r;
                    u32x4 w; w.x = cvt_pk_bf16(silu_mul(g0[0], u0[0]), silu_mul(g0[1], u0[1])); w.y = cvt_pk_bf16(silu_mul(g0[2], u0[2]), silu_mul(g0[3], u0[3]));
                    w.z = cvt_pk_bf16(silu_mul(g1[0], u1[0]), silu_mul(g1[1], u1[1])); w.w = cvt_pk_bf16(silu_mul(g1[2], u1[2]), silu_mul(g1[3], u1[3]));
                    *(u32x4*)rowp = w;
                } else {
                    float ssr = 0.f;
#pragma unroll
                    for (int bj = 0; bj < 2; ++bj) { f32x4 v0 = acc[ai][bj][m][0] * cs[bj][0] * r, v1 = acc[ai][bj][m][1] * cs[bj][1] * r;
                        if (act) { v0 = gelu4(v0); v1 = gelu4(v1); }
                        ssr += (v0[0] * v0[0] + v0[1] * v0[1]) + (v0[2] * v0[2] + v0[3] * v0[3]) + (v1[0] * v1[0] + v1[1] * v1[1]) + (v1[2] * v1[2] + v1[3] * v1[3]);
                        u32x4 w; w.x = cvt_pk_bf16(v0[0], v0[1]); w.y = cvt_pk_bf16(v0[2], v0[3]); w.z = cvt_pk_bf16(v1[0], v1[1]); w.w = cvt_pk_bf16(v1[2], v1[3]);
                        *(u32x4*)(rowp + bj * HALF) = w; }
                    if (stat) { ssr += __shfl_xor(ssr, 16); ssr += __shfl_xor(ssr, 32); if (fq == 0) atomicAdd(ssp + row, ssr); }
                }
            }
    }
};

__device__ __forceinline__ void gemm_phase(PG8_LAS unsigned char* lds, const Gemm g, const StaticOrder& S, const Epi& E, const int tid) {
    const int wid = __builtin_amdgcn_readfirstlane(tid >> 6), lane = tid & 63, wr = wid >> 2, wc = wid & 3, fr = lane & 15, fq = lane >> 4;
    const int K = g.K, nt = K / BK;
    unsigned voffA[2], voffB[2];
#pragma unroll
    for (int i = 0; i < 2; ++i) { int R, C; stage_rc(tid * 16 + i * 8192, R, C); const int Rb = (R & ~31) + perm32(R & 31);
        voffA[i] = (unsigned)(R * g.lda + C) * 2u; voffB[i] = (unsigned)(Rb * g.ldb + C) * 2u; }
    const size_t kstep = (size_t)(BK * 2);
    const size_t hstepA = (size_t)HALF * g.lda * 2, hstepB = (size_t)HALF * g.ldb * 2;
    const size_t tstepA = 2 * hstepA, tstepB = 2 * hstepB;
    const unsigned ldsw = (unsigned)wid * 1024u;
    const int aoff = lds_byte(wr * 64 + fr, fq * 8), boff = lds_byte(wc * 32 + fr, fq * 8);
#define PG8_SA(b, h) (((b) * 2 + (h)) * HTB)
#define PG8_SB(b, h) ((4 + (b) * 2 + (h)) * HTB)
#define PG8_STAGE(bufoff, gbase, voff) do { _Pragma("unroll") for (int _i = 0; _i < 2; ++_i) \
        __builtin_amdgcn_global_load_lds((const unsigned*)((const char*)(gbase) + (voff)[_i]), (PG8_LAS unsigned*)(lds + (bufoff) + ldsw + _i * 8192), 16, 0, 0); } while (0)
#define PG8_LDA(dst, b, h) do { _Pragma("unroll") for (int m = 0; m < 4; ++m) _Pragma("unroll") for (int k = 0; k < 2; ++k) dst[m][k] = *(const PG8_LAS bf16x8*)(lds + PG8_SA(b, h) + aoff + m * 2048 + k * 1024); } while (0)
#define PG8_LDB(dst, b, h) do { _Pragma("unroll") for (int n = 0; n < 2; ++n) _Pragma("unroll") for (int k = 0; k < 2; ++k) dst[n][k] = *(const PG8_LAS bf16x8*)(lds + PG8_SB(b, h) + boff + n * 2048 + k * 1024); } while (0)
#define PG8_MMA(ai, bj, At, Bt) do { __builtin_amdgcn_s_setprio(1); _Pragma("unroll") for (int m = 0; m < 4; ++m) _Pragma("unroll") for (int n = 0; n < 2; ++n) _Pragma("unroll") for (int k = 0; k < 2; ++k) \
        acc[ai][bj][m][n] = __builtin_amdgcn_mfma_f32_16x16x32_bf16(Bt[n][k], At[m][k], acc[ai][bj][m][n], 0, 0, 0); __builtin_amdgcn_s_setprio(0); } while (0)
#define PG8_WAIT_V(n) asm volatile("s_waitcnt vmcnt(" #n ")" ::: "memory")
#define PG8_WAIT_L(n) asm volatile("s_waitcnt lgkmcnt(" #n ")" ::: "memory")
#define PG8_BAR __builtin_amdgcn_s_barrier()
#define PG8_SCHED __builtin_amdgcn_sched_barrier(0)
    Unit cur, nxt; int ui = 0;
    if (!S.next(0, cur)) return;
    f32x4 acc[2][2][4][2];
#pragma unroll
    for (int a = 0; a < 2; ++a)
#pragma unroll
        for (int b = 0; b < 2; ++b)
#pragma unroll
            for (int m = 0; m < 4; ++m)
#pragma unroll
                for (int n = 0; n < 2; ++n) acc[a][b][m][n] = (f32x4){0.f, 0.f, 0.f, 0.f};
    bf16x8 At[4][2], B0[2][2], B1[2][2];
    const char* cA = (const char*)g.A + (size_t)cur.pm * tstepA; const char* cB = (const char*)g.Bt + (size_t)cur.pn * tstepB;
    PG8_STAGE(PG8_SB(0, 0), cB, voffB); PG8_STAGE(PG8_SB(0, 1), cB + hstepB, voffB); PG8_STAGE(PG8_SA(0, 0), cA, voffA); PG8_STAGE(PG8_SA(0, 1), cA + hstepA, voffA);
    if (wr == 1) PG8_BAR;
    PG8_WAIT_V(2); PG8_BAR;
    PG8_STAGE(PG8_SB(1, 0), cB + kstep, voffB); PG8_STAGE(PG8_SA(1, 0), cA + kstep, voffA); PG8_STAGE(PG8_SB(1, 1), cB + hstepB + kstep, voffB);
    PG8_WAIT_V(6); PG8_BAR;
    for (;;) {
        const bool has_next = S.next(ui + 1, nxt);
        const char* nA = has_next ? (const char*)g.A + (size_t)nxt.pm * tstepA : cA; const char* nB = has_next ? (const char*)g.Bt + (size_t)nxt.pn * tstepB : cB;
        for (int t = 0; t < nt; t += 2) {
            const bool last = (t == nt - 2);
            const char* a1 = cA + (size_t)(t + 1) * kstep;
            const char* a2 = last ? nA : cA + (size_t)(t + 2) * kstep; const char* b2 = last ? nB : cB + (size_t)(t + 2) * kstep;
            const char* a3 = a2 + kstep; const char* b3 = b2 + kstep;
            PG8_LDB(B0, 0, 0); PG8_LDB(B1, 0, 1); PG8_SCHED; PG8_LDA(At, 0, 0); PG8_STAGE(PG8_SA(1, 1), a1 + hstepA, voffA);
            PG8_WAIT_V(8); PG8_WAIT_L(0); PG8_BAR; PG8_MMA(0, 0, At, B0); PG8_MMA(0, 1, At, B1); PG8_BAR; PG8_SCHED;
            PG8_LDA(At, 0, 1); PG8_STAGE(PG8_SB(0, 0), b2, voffB); PG8_STAGE(PG8_SB(0, 1), b2 + hstepB, voffB); PG8_STAGE(PG8_SA(0, 0), a2, voffA);
            PG8_WAIT_V(8); PG8_WAIT_L(0); PG8_BAR; PG8_MMA(1, 0, At, B0); PG8_MMA(1, 1, At, B1); PG8_BAR; PG8_SCHED;
            PG8_LDB(B0, 1, 0); PG8_LDB(B1, 1, 1); PG8_SCHED; PG8_LDA(At, 1, 0); PG8_STAGE(PG8_SA(0, 1), a2 + hstepA, voffA);
            PG8_WAIT_V(8); PG8_WAIT_L(0); PG8_BAR; PG8_MMA(0, 0, At, B0); PG8_MMA(0, 1, At, B1); PG8_BAR; PG8_SCHED;
            PG8_LDA(At, 1, 1); PG8_STAGE(PG8_SB(1, 0), b3, voffB); PG8_STAGE(PG8_SB(1, 1), b3 + hstepB, voffB); PG8_STAGE(PG8_SA(1, 0), a3, voffA);
            PG8_WAIT_V(8); PG8_WAIT_L(0); PG8_BAR; PG8_MMA(1, 0, At, B0); PG8_MMA(1, 1, At, B1); PG8_BAR; PG8_SCHED;
        }
        if (wr == 0) PG8_BAR;
        E(acc, cur, wr, wc, fr, fq);
        if (!has_next) break;
#pragma unroll
        for (int a = 0; a < 2; ++a)
#pragma unroll
            for (int b = 0; b < 2; ++b)
#pragma unroll
                for (int m = 0; m < 4; ++m)
#pragma unroll
                    for (int n = 0; n < 2; ++n) acc[a][b][m][n] = (f32x4){0.f, 0.f, 0.f, 0.f};
        cur = nxt; cA = nA; cB = nB; ++ui;
        if (wr == 1) PG8_BAR;
    }
    PG8_WAIT_V(0);
    PG8_BAR;
#undef PG8_SA
#undef PG8_SB
#undef PG8_STAGE
#undef PG8_LDA
#undef PG8_LDB
#undef PG8_MMA
#undef PG8_WAIT_V
#undef PG8_WAIT_L
#undef PG8_BAR
#undef PG8_SCHED
}
}

#define LAS __attribute__((address_space(3)))
typedef unsigned short bf16;
typedef float f32x4 __attribute__((ext_vector_type(4)));
typedef float f32x16 __attribute__((ext_vector_type(16)));
typedef short bf16x8 __attribute__((ext_vector_type(8)));
typedef unsigned u32x4 __attribute__((ext_vector_type(4)));
typedef unsigned u32x2 __attribute__((ext_vector_type(2)));
using pg8::cvt_pk_bf16;
__device__ __forceinline__ float bf_lo(unsigned u) { return __uint_as_float(u << 16); }
__device__ __forceinline__ float bf_hi(unsigned u) { return __uint_as_float(u & 0xffff0000u); }
__device__ __forceinline__ float wave_sum(float v) {
#pragma unroll
    for (int o = 1; o < 64; o <<= 1) v += __shfl_xor(v, o);
    return v;
}

constexpr size_t MiB = 1u << 20;
constexpr size_t WS_WGU1 = 2 * MiB, WS_WD1 = 46 * MiB, WS_WGU2 = 68 * MiB, WS_WD2 = 112 * MiB, WS_WIN = 134 * MiB, WS_WQ = 147 * MiB + MiB / 2, WS_WK = 149 * MiB, WS_WV = 150 * MiB, WS_WOUT = 151 * MiB;
constexpr size_t WS_SS = 0;
constexpr size_t WS_XB2 = 632 * MiB;
constexpr size_t WS_XN = 160 * MiB;
constexpr size_t WS_Y = WS_XN;
constexpr size_t WS_H = 288 * MiB;
constexpr size_t WS_Z = 288 * MiB;
constexpr size_t WS_QRAW = 496 * MiB;
constexpr size_t WS_KRAW = 632 * MiB;
constexpr size_t WS_VT = 696 * MiB;
constexpr size_t WS_Q = 760 * MiB;
constexpr size_t WS_K = 856 * MiB;
constexpr size_t WS_END = 952 * MiB;
static_assert(WS_WGU1 + (size_t)NGU * DM * 2 <= WS_WD1 && WS_WD1 + (size_t)DM * DFF * 2 <= WS_WGU2 && WS_WGU2 + (size_t)NGU * DM * 2 <= WS_WD2 && WS_WD2 + (size_t)DM * DFF * 2 <= WS_WIN, "ws map 1");
static_assert(WS_WIN + (size_t)ZLD * DM * 2 <= WS_WQ && WS_WQ + (size_t)QW * 512 * 2 <= WS_WK && WS_WK + 1024 * 512 * 2 <= WS_WV && WS_WV + 1024 * 512 * 2 <= WS_WOUT && WS_WOUT + (size_t)DM * DM * 2 <= WS_XN, "ws map 2");
static_assert(WS_XN + (size_t)MTOK * DM * 2 <= WS_H && WS_H + (size_t)MTOK * DFF * 2 <= WS_KRAW && WS_Z + (size_t)MTOK * ZLD * 2 <= WS_QRAW && WS_QRAW + (size_t)MTOK * QW * 2 <= WS_KRAW, "ws map 3");
static_assert(WS_KRAW + (size_t)MTOK * 1024 * 2 <= WS_VT && WS_VT + (size_t)MTOK * 1024 * 2 <= WS_Q && WS_Q + (size_t)MTOK * QW * 2 <= WS_K && WS_K + (size_t)MTOK * QW * 2 <= WS_END, "ws map 4");

__device__ __forceinline__ unsigned f2bf(float f) { unsigned u = __builtin_bit_cast(unsigned, f); return (u + 0x7fffu + ((u >> 16) & 1u)) >> 16; }
__device__ __forceinline__ unsigned pk2(float lo, float hi) { return f2bf(lo) | (f2bf(hi) << 16); }
__device__ __forceinline__ void transpose_item(const float* W, int N, bf16* dst  , int K, int k0, int n0, LAS float* scr, int lane, const float* gk  ) {
    float wv[32];
#pragma unroll
    for (int i = 0; i < 32; ++i) { const int kk = 2 * i + (lane >> 5); wv[i] = W[(size_t)(k0 + kk) * N + n0 + (lane & 31)]; }
    if (gk) {
#pragma unroll
        for (int i = 0; i < 32; ++i) wv[i] *= gk[k0 + 2 * i + (lane >> 5)];
    }
#pragma unroll
    for (int i = 0; i < 32; ++i) { const int kk = 2 * i + (lane >> 5); scr[kk * 33 + (lane & 31)] = wv[i]; }
    asm volatile("s_waitcnt lgkmcnt(0)" ::: "memory");
    const int c = lane & 7;
#pragma unroll
    for (int j = 0; j < 4; ++j) { const int n = (lane >> 3) + 8 * j; const LAS float* s = scr + (8 * c) * 33 + n;
        u32x4 o; o.x = pk2(s[0 * 33], s[1 * 33]); o.y = pk2(s[2 * 33], s[3 * 33]); o.z = pk2(s[4 * 33], s[5 * 33]); o.w = pk2(s[6 * 33], s[7 * 33]);
        *(u32x4*)(dst + (size_t)n * K + k0 + 8 * c) = o; }
    asm volatile("s_waitcnt lgkmcnt(0)" ::: "memory");
}
__device__ __forceinline__ void rms_row_to_bf16(const float* xrow, const float* g, bf16* orow, int lane) {
    const f32x4* xr = (const f32x4*)xrow + lane; const f32x4* gr = (const f32x4*)g + lane;
    f32x4 v[8]; float s = 0.f;
#pragma unroll
    for (int j = 0; j < 8; ++j) { v[j] = xr[64 * j]; s += (v[j].x * v[j].x + v[j].y * v[j].y) + (v[j].z * v[j].z + v[j].w * v[j].w); }
    const float r = 1.0f / sqrtf(wave_sum(s) * (1.0f / DM) + EPS);
    u32x2* o8 = (u32x2*)orow + lane;
#pragma unroll
    for (int j = 0; j < 8; ++j) { const f32x4 gg = gr[64 * j]; u32x2 w; w.x = cvt_pk_bf16(v[j].x * r * gg.x, v[j].y * r * gg.y); w.y = cvt_pk_bf16(v[j].z * r * gg.z, v[j].w * r * gg.w); o8[64 * j] = w; }
}

__device__ __forceinline__ void p0_weights(LAS unsigned char* lds, unsigned char* ws, const float* wg1, const float* wu1, const float* wd1, const float* wg2, const float* wu2, const float* wd2,
                                           const float* win, const float* wq, const float* wkv, const float* wout, const float* g_mix, const float* g_ffn2, const float* g_q, const float* g_kv, int gw, int NGW, int wave, int lane) {
    LAS float* scr = (LAS float*)(lds + wave * 8448);
    constexpr int I_F = (DM / 64) * (DFF / 32);
    constexpr int I_IN = (DM / 64) * (3136 / 32), I_Q = (512 / 64) * (QW / 32), I_KV = (512 / 64) * (2048 / 32), I_O = (DM / 64) * (DM / 32);
    constexpr int NITEMS = 6 * I_F + I_IN + I_Q + I_KV + I_O;
    for (int it = gw; it < NITEMS; it += NGW) {
        int r = it;
        if (r < 6 * I_F) {
            const int which = r / I_F; r -= which * I_F; const int ffn = which / 3, kind = which % 3;
            if (kind < 2) { const float* W = wg1; if (which == 1) W = wu1; if (which == 3) W = wg2; if (which == 4) W = wu2; bf16* D = (bf16*)(ws + (ffn ? WS_WGU2 : WS_WGU1));
                const int nblk = DFF / 32, kb = r / nblk, nb = r % nblk, n0 = nb * 32; const int drow = (n0 / 128) * 256 + (n0 % 128) + kind * 128;
                transpose_item(W, DFF, D + (size_t)drow * DM, DM, kb * 64, n0, scr, lane, ffn ? g_ffn2 : nullptr); }
            else { const float* W = wd1; if (ffn) W = wd2; bf16* D = (bf16*)(ws + (ffn ? WS_WD2 : WS_WD1));
                const int nblk = DM / 32, kb = r / nblk, nb = r % nblk, n0 = nb * 32;
                transpose_item(W, DM, D + (size_t)n0 * DFF, DFF, kb * 64, n0, scr, lane, nullptr); }
            continue;
        }
        r -= 6 * I_F;
        if (r < I_IN) { const int nblk = 3136 / 32, kb = r / nblk, nb = r % nblk, n0 = nb * 32; transpose_item(win, 3136, (bf16*)(ws + WS_WIN) + (size_t)n0 * DM, DM, kb * 64, n0, scr, lane, g_mix); continue; }
        r -= I_IN;
        if (r < I_Q) { const int nblk = QW / 32, kb = r / nblk, nb = r % nblk, n0 = nb * 32; transpose_item(wq, QW, (bf16*)(ws + WS_WQ) + (size_t)n0 * 512, 512, kb * 64, n0, scr, lane, g_q); continue; }
        r -= I_Q;
        if (r < I_KV) { const int nblk = 2048 / 32, kb = r / nblk, nb = r % nblk, n0 = nb * 32; const int h = n0 >> 8, c = n0 & 255;
            bf16* D = (c < 128) ? (bf16*)(ws + WS_WK) + (size_t)(h * 128 + c) * 512 : (bf16*)(ws + WS_WV) + (size_t)(h * 128 + c - 128) * 512;
            transpose_item(wkv, 2048, D, 512, kb * 64, n0, scr, lane, g_kv); continue; }
        r -= I_KV;
        { const int nblk = DM / 32, kb = r / nblk, nb = r % nblk, n0 = nb * 32; transpose_item(wout, DM, (bf16*)(ws + WS_WOUT) + (size_t)n0 * DM, DM, kb * 64, n0, scr, lane, nullptr); }
    }
    { float* ssz = (float*)(ws + WS_SS); for (int i = gw * 64 + lane; i < 5 * MTOK; i += NGW * 64) ssz[i] = 0.f; }
    { u32x4* z = (u32x4*)((bf16*)(ws + WS_WIN) + (size_t)3136 * DM); const int n16 = (ZLD - 3136) * DM * 2 / 16;
      for (int i = gw * 64 + lane; i < n16; i += NGW * 64) z[i] = (u32x4){0u, 0u, 0u, 0u}; }
}

__device__ __forceinline__ void znorm_seg16(bf16* p, const float* g, float invn, int lane, int nvec  ) {
    u32x4 a[2]; float s = 0.f;
#pragma unroll
    for (int j = 0; j < 2; ++j) if (j < nvec) { a[j] = *(const u32x4*)(p + j * 512 + lane * 8);
#pragma unroll
        for (int k = 0; k < 4; ++k) { const float lo = bf_lo(a[j][k]), hi = bf_hi(a[j][k]); s += lo * lo + hi * hi; } }
    const float r = 1.0f / sqrtf(wave_sum(s) * invn + EPS);
#pragma unroll
    for (int j = 0; j < 2; ++j) if (j < nvec) { const f32x4 g0 = *(const f32x4*)(g + j * 512 + lane * 8), g1 = *(const f32x4*)(g + j * 512 + lane * 8 + 4); u32x4 w;
        w.x = cvt_pk_bf16(bf_lo(a[j].x) * r * g0.x, bf_hi(a[j].x) * r * g0.y); w.y = cvt_pk_bf16(bf_lo(a[j].y) * r * g0.z, bf_hi(a[j].y) * r * g0.w);
        w.z = cvt_pk_bf16(bf_lo(a[j].z) * r * g1.x, bf_hi(a[j].z) * r * g1.y); w.w = cvt_pk_bf16(bf_lo(a[j].w) * r * g1.z, bf_hi(a[j].w) * r * g1.w);
        *(u32x4*)(p + j * 512 + lane * 8) = w; }
}

__device__ const double ROPE_REV[32] = {0.15915494309189535, 0.11934937021124886, 0.08949940160889101, 0.06711508300522726, 0.050329212104487035, 0.03774158471741977, 0.0283021958306234, 0.02122365276477766,
    0.015915494309189534, 0.011934937021124886, 0.008949940160889102, 0.006711508300522725, 0.005032921210448704, 0.003774158471741977, 0.00283021958306234, 0.0021223652764777662,
    0.0015915494309189536, 0.0011934937021124885, 0.0008949940160889102, 0.0006711508300522726, 0.0005032921210448703, 0.00037741584717419774, 0.00028302195830623395, 0.0002122365276477766,
    0.00015915494309189535, 0.00011934937021124886, 8.949940160889102e-05, 6.711508300522725e-05, 5.0329212104487035e-05, 3.774158471741978e-05, 2.8302195830623396e-05, 2.122365276477766e-05};
constexpr float QSCALE = 0.07216878364870322f * 1.4426950408889634f;
struct QKIn { u32x4 a0, a1; u32x2 r1, r2; };
__device__ __forceinline__ QKIn qk_load(const bf16* nope, const bf16* rope, int j) {
    QKIn q; q.a0 = *(const u32x4*)(nope + 16 * j); q.a1 = *(const u32x4*)(nope + 16 * j + 8); q.r1 = *(const u32x2*)(rope + 4 * j); q.r2 = *(const u32x2*)(rope + 32 + 4 * j); return q;
}
__device__ __forceinline__ void qk_finish(const QKIn& in, const float* g, bf16* dst, const float (&cs)[4], const float (&sn)[4], int j, float oscale) {
    const u32x4 a0 = in.a0, a1 = in.a1; const u32x2 r1 = in.r1, r2 = in.r2;
    float x[16], y1[4], y2[4];
#pragma unroll
    for (int k = 0; k < 4; ++k) { x[2 * k] = bf_lo(a0[k]); x[2 * k + 1] = bf_hi(a0[k]); x[8 + 2 * k] = bf_lo(a1[k]); x[8 + 2 * k + 1] = bf_hi(a1[k]); }
    y1[0] = bf_lo(r1.x); y1[1] = bf_hi(r1.x); y1[2] = bf_lo(r1.y); y1[3] = bf_hi(r1.y);
    y2[0] = bf_lo(r2.x); y2[1] = bf_hi(r2.x); y2[2] = bf_lo(r2.y); y2[3] = bf_hi(r2.y);
    float s = 0.f;
#pragma unroll
    for (int k = 0; k < 16; ++k) s += x[k] * x[k];
#pragma unroll
    for (int k = 0; k < 4; ++k) s += y1[k] * y1[k] + y2[k] * y2[k];
    s += __shfl_xor(s, 1); s += __shfl_xor(s, 2); s += __shfl_xor(s, 4);
    const float r = 1.0f / sqrtf(s * (1.0f / QKD) + EPS);
    const f32x4 g0 = *(const f32x4*)(g + 16 * j), g1 = *(const f32x4*)(g + 16 * j + 4), g2 = *(const f32x4*)(g + 16 * j + 8), g3 = *(const f32x4*)(g + 16 * j + 12);
    const f32x4 ga = *(const f32x4*)(g + 128 + 4 * j), gb = *(const f32x4*)(g + 160 + 4 * j);
    const float ro = r * oscale;
    u32x4 w0, w1;
    w0.x = cvt_pk_bf16(x[0] * ro * g0.x, x[1] * ro * g0.y); w0.y = cvt_pk_bf16(x[2] * ro * g0.z, x[3] * ro * g0.w); w0.z = cvt_pk_bf16(x[4] * ro * g1.x, x[5] * ro * g1.y); w0.w = cvt_pk_bf16(x[6] * ro * g1.z, x[7] * ro * g1.w);
    w1.x = cvt_pk_bf16(x[8] * ro * g2.x, x[9] * ro * g2.y); w1.y = cvt_pk_bf16(x[10] * ro * g2.z, x[11] * ro * g2.w); w1.z = cvt_pk_bf16(x[12] * ro * g3.x, x[13] * ro * g3.y); w1.w = cvt_pk_bf16(x[14] * ro * g3.z, x[15] * ro * g3.w);
    *(u32x4*)(dst + 16 * j) = w0; *(u32x4*)(dst + 16 * j + 8) = w1;
    float o1[4], o2[4];
#pragma unroll
    for (int k = 0; k < 4; ++k) { const float a = y1[k] * r * ga[k], b = y2[k] * r * gb[k]; o1[k] = (a * cs[k] - b * sn[k]) * oscale; o2[k] = (b * cs[k] + a * sn[k]) * oscale; }
    u32x2 v1, v2; v1.x = cvt_pk_bf16(o1[0], o1[1]); v1.y = cvt_pk_bf16(o1[2], o1[3]); v2.x = cvt_pk_bf16(o2[0], o2[1]); v2.y = cvt_pk_bf16(o2[2], o2[3]);
    *(u32x2*)(dst + 128 + 4 * j) = v1; *(u32x2*)(dst + 160 + 4 * j) = v2;
}
__device__ __forceinline__ void rope_cs(int pos, int j, float (&cs)[4], float (&sn)[4]) {
#pragma unroll
    for (int k = 0; k < 4; ++k) { const double rev = (double)pos * ROPE_REV[4 * j + k]; const float fr = (float)(rev - __builtin_floor(rev)); cs[k] = __builtin_amdgcn_cosf(fr); sn[k] = __builtin_amdgcn_sinf(fr); }
}
__device__ __forceinline__ void qk_token2(int t0, int t1, const int* positions, const bf16* Qraw, const bf16* Kraw, const bf16* Z, const float* qg, const float* kg, bf16* Q, bf16* K, int lane) {
    const int h = lane >> 3, j = lane & 7; const int p0 = positions[t0], p1 = positions[t1];
    const QKIn q0 = qk_load(Qraw + (size_t)t0 * QW + h * QKD, Qraw + (size_t)t0 * QW + h * QKD + 128, j), k0 = qk_load(Kraw + (size_t)t0 * 1024 + h * 128, Z + (size_t)t0 * ZLD + 3072, j);
    const QKIn q1 = qk_load(Qraw + (size_t)t1 * QW + h * QKD, Qraw + (size_t)t1 * QW + h * QKD + 128, j), k1 = qk_load(Kraw + (size_t)t1 * 1024 + h * 128, Z + (size_t)t1 * ZLD + 3072, j);
    float cs[4], sn[4];
    rope_cs(p0, j, cs, sn);
    qk_finish(q0, qg, Q + (size_t)t0 * QW + h * QKD, cs, sn, j, QSCALE); qk_finish(k0, kg, K + (size_t)t0 * QW + h * QKD, cs, sn, j, 1.0f);
    rope_cs(p1, j, cs, sn);
    qk_finish(q1, qg, Q + (size_t)t1 * QW + h * QKD, cs, sn, j, QSCALE); qk_finish(k1, kg, K + (size_t)t1 * QW + h * QKD, cs, sn, j, 1.0f);
}

namespace att {
constexpr int KP = 400, VP = 144, KBYTES = 64 * KP, VBYTES = 128 * VP, STAGE = KBYTES + VBYTES;
#define MFMA32(a, b, c) __builtin_amdgcn_mfma_f32_32x32x16_bf16((a), (b), (c), 0, 0, 0)
__device__ __forceinline__ void attn_unit(LAS unsigned char* lds, const bf16* Q, const bf16* K, const bf16* Vt, bf16* Y, const float* gout, int b, int h, int qb, const int tid) {
    const int lane = tid & 63, r32 = lane & 31, hi = lane >> 5; const int wid = __builtin_amdgcn_readfirstlane(tid >> 6);
    const int q0 = qb * 256, qrow = q0 + wid * 32 + r32;
    const size_t tok0 = (size_t)b * SEQ;
    bf16x8 qf[12];
    { const bf16* qp = Q + (tok0 + qrow) * QW + h * QKD + hi * 8;
#pragma unroll
      for (int dk = 0; dk < 12; ++dk) qf[dk] = *(const bf16x8*)(qp + dk * 16); }
    const bf16* ksrc = K + (tok0 + (tid >> 3)) * QW + h * QKD + (tid & 7) * 8;
    const unsigned kdst = (tid >> 3) * KP + (tid & 7) * 16;
    const bf16* vsrc = Vt + (size_t)(h * VD + (tid >> 2)) * MTOK + tok0 + (tid & 3) * 8;
    const unsigned vdst = KBYTES + (tid >> 2) * VP + (tid & 3) * 16;
    const int NT = 4 * (qb + 1), my_last = 4 * qb + (wid >> 1);
    u32x4 kr[3], vr[2];
#pragma unroll
    for (int i = 0; i < 3; ++i) kr[i] = *(const u32x4*)(ksrc + i * 64);
#pragma unroll
    for (int i = 0; i < 2; ++i) vr[i] = *(const u32x4*)(vsrc + i * 32);
    __syncthreads();
#pragma unroll
    for (int i = 0; i < 3; ++i) *(LAS u32x4*)(lds + kdst + i * 128) = kr[i];
#pragma unroll
    for (int i = 0; i < 2; ++i) *(LAS u32x4*)(lds + vdst + i * 64) = vr[i];
    __syncthreads();
    const int pim = (r32 & 16) + ((r32 >> 2) & 1) * 8 + ((r32 >> 3) & 1) * 4 + (r32 & 3);
    const unsigned koff = pim * KP + hi * 16, voff = KBYTES + r32 * VP + hi * 16;
    f32x16 o[4];
#pragma unroll
    for (int d = 0; d < 4; ++d)
#pragma unroll
        for (int r = 0; r < 16; ++r) o[d][r] = 0.f;
    float m_run = -1e30f, l_run = 0.f;
    for (int t = 0; t < NT; ++t) {
        const unsigned bo = (t & 1) * STAGE;
        const bool more = (t + 1 < NT);
        if (more) {
#pragma unroll
            for (int i = 0; i < 3; ++i) kr[i] = *(const u32x4*)(ksrc + (size_t)(t + 1) * 64 * QW + i * 64);
#pragma unroll
            for (int i = 0; i < 2; ++i) vr[i] = *(const u32x4*)(vsrc + (t + 1) * 64 + i * 32);
        }
        if (t <= my_last) {
            f32x16 s0, s1;
#pragma unroll
            for (int r = 0; r < 16; ++r) { s0[r] = 0.f; s1[r] = 0.f; }
#pragma unroll
            for (int dk = 0; dk < 12; ++dk) {
                const bf16x8 k0 = *(const LAS bf16x8*)(lds + bo + koff + dk * 32), k1 = *(const LAS bf16x8*)(lds + bo + koff + 32 * KP + dk * 32);
                s0 = MFMA32(k0, qf[dk], s0); s1 = MFMA32(k1, qf[dk], s1);
            }
            if (t >= 4 * qb) {
                const int kb0 = 64 * t + 8 * hi;
#pragma unroll
                for (int r = 0; r < 16; ++r) { const int key = kb0 + 16 * (r >> 3) + (r & 7); if (key > qrow) s0[r] = -1e30f; if (key + 32 > qrow) s1[r] = -1e30f; }
            }
            float mx = s0[0];
#pragma unroll
            for (int r = 1; r < 16; ++r) mx = fmaxf(mx, s0[r]);
#pragma unroll
            for (int r = 0; r < 16; ++r) mx = fmaxf(mx, s1[r]);
            mx = fmaxf(mx, __shfl_xor(mx, 32));
            const float m_new = fmaxf(m_run, mx), alpha = __builtin_amdgcn_exp2f(m_run - m_new);
            m_run = m_new;
            float ls = 0.f;
#pragma unroll
            for (int r = 0; r < 16; ++r) { s0[r] = __builtin_amdgcn_exp2f(s0[r] - m_new); s1[r] = __builtin_amdgcn_exp2f(s1[r] - m_new); ls += s0[r] + s1[r]; }
            l_run = l_run * alpha + ls;
#pragma unroll
            for (int d = 0; d < 4; ++d)
#pragma unroll
                for (int r = 0; r < 16; ++r) o[d][r] *= alpha;
            u32x4 pw[4];
#pragma unroll
            for (int c = 0; c < 2; ++c) {
                pw[c] = (u32x4){cvt_pk_bf16(s0[8 * c], s0[8 * c + 1]), cvt_pk_bf16(s0[8 * c + 2], s0[8 * c + 3]), cvt_pk_bf16(s0[8 * c + 4], s0[8 * c + 5]), cvt_pk_bf16(s0[8 * c + 6], s0[8 * c + 7])};
                pw[2 + c] = (u32x4){cvt_pk_bf16(s1[8 * c], s1[8 * c + 1]), cvt_pk_bf16(s1[8 * c + 2], s1[8 * c + 3]), cvt_pk_bf16(s1[8 * c + 4], s1[8 * c + 5]), cvt_pk_bf16(s1[8 * c + 6], s1[8 * c + 7])};
            }
#pragma unroll
            for (int kc = 0; kc < 4; ++kc) {
                const bf16x8 pf = __builtin_bit_cast(bf16x8, pw[kc]);
#pragma unroll
                for (int d = 0; d < 4; ++d) { const bf16x8 vf = *(const LAS bf16x8*)(lds + bo + voff + d * 32 * VP + kc * 32); o[d] = MFMA32(vf, pf, o[d]); }
            }
        }
        if (more) {
            const unsigned nb = ((t + 1) & 1) * STAGE;
#pragma unroll
            for (int i = 0; i < 3; ++i) *(LAS u32x4*)(lds + nb + kdst + i * 128) = kr[i];
#pragma unroll
            for (int i = 0; i < 2; ++i) *(LAS u32x4*)(lds + nb + vdst + i * 64) = vr[i];
        }
        __syncthreads();
    }
    const float l = l_run + __shfl_xor(l_run, 32), inv = 1.0f / l;
    float ss = 0.f;
#pragma unroll
    for (int d = 0; d < 4; ++d)
#pragma unroll
        for (int r = 0; r < 16; ++r) { o[d][r] *= inv; ss += o[d][r] * o[d][r]; }
    ss += __shfl_xor(ss, 32);
    const float rn = 1.0f / sqrtf(ss * (1.0f / VD) + EPS);
    bf16* yp = Y + (tok0 + qrow) * DM + 1024 + h * VD + 4 * hi; const float* gp = gout + h * VD + 4 * hi;
#pragma unroll
    for (int d = 0; d < 4; ++d)
#pragma unroll
        for (int r4 = 0; r4 < 4; ++r4) { const f32x4 g = *(const f32x4*)(gp + 32 * d + 8 * r4); u32x2 w;
            w.x = cvt_pk_bf16(o[d][4 * r4] * rn * g.x, o[d][4 * r4 + 1] * rn * g.y); w.y = cvt_pk_bf16(o[d][4 * r4 + 2] * rn * g.z, o[d][4 * r4 + 3] * rn * g.w);
            *(u32x2*)(yp + 32 * d + 8 * r4) = w; }
}
}

namespace gm {
constexpr int WP = 272;
constexpr int WBYTES = 128 * WP;
__device__ __forceinline__ void gmlp_phase(LAS unsigned char* lds, const bf16* Z, const float* w_s, const float* b_s, const float* gout, const float* ssv, const float* gv, bf16* Y, int vcu, int G, const int tid) {
    const int lane = tid & 63, l16 = lane & 15, q4 = lane >> 4; const int wid = __builtin_amdgcn_readfirstlane(tid >> 6);
    int gcur = -1;
    u32x4 vreg[4]; float rvreg[4];
    if (vcu < 2048) { const int g = vcu & 7; const size_t tok0 = (size_t)(vcu >> 3) * 128;
#pragma unroll
        for (int i = 0; i < 4; ++i) { const int p = tid + 512 * i, s = p >> 4, seg = p & 15; vreg[i] = *(const u32x4*)(Z + (tok0 + s) * ZLD + 1024 + g * 128 + seg * 8); rvreg[i] = ssv[tok0 + s]; } }
    for (int un = vcu; un < 2048; un += G) {
        const int g = un & 7, bc = un >> 3;
        const size_t tok0 = (size_t)bc * 128;
        __syncthreads();
        if (g != gcur) {
            gcur = g;
#pragma unroll
            for (int i = 0; i < 8; ++i) { const int p = tid + 512 * i, t = p >> 5, s = (p & 31) * 4; const f32x4 w = *(const f32x4*)(w_s + (size_t)g * 16384 + t * 128 + s);
                u32x2 o; o.x = cvt_pk_bf16(s <= t ? w.x : 0.f, s + 1 <= t ? w.y : 0.f); o.y = cvt_pk_bf16(s + 2 <= t ? w.z : 0.f, s + 3 <= t ? w.w : 0.f);
                *(LAS u32x2*)(lds + t * WP + s * 2) = o; }
        }
#pragma unroll
        for (int i = 0; i < 4; ++i) { const int p = tid + 512 * i, s = p >> 4, seg = p & 15; const u32x4 v = vreg[i];
            const float rv = __builtin_amdgcn_rsqf(rvreg[i] * (1.0f / 1024.0f) + EPS); const f32x4 g0 = *(const f32x4*)(gv + g * 128 + seg * 8), g1 = *(const f32x4*)(gv + g * 128 + seg * 8 + 4);
            LAS unsigned short* dst = (LAS unsigned short*)(lds + WBYTES + (seg * 8) * WP + s * 2);
            const unsigned w0 = cvt_pk_bf16(bf_lo(v.x) * rv * g0.x, bf_hi(v.x) * rv * g0.y), w1 = cvt_pk_bf16(bf_lo(v.y) * rv * g0.z, bf_hi(v.y) * rv * g0.w);
            const unsigned w2 = cvt_pk_bf16(bf_lo(v.z) * rv * g1.x, bf_hi(v.z) * rv * g1.y), w3 = cvt_pk_bf16(bf_lo(v.w) * rv * g1.z, bf_hi(v.w) * rv * g1.w);
            dst[0 * (WP / 2)] = (unsigned short)(w0 & 0xffffu); dst[1 * (WP / 2)] = (unsigned short)(w0 >> 16); dst[2 * (WP / 2)] = (unsigned short)(w1 & 0xffffu); dst[3 * (WP / 2)] = (unsigned short)(w1 >> 16);
            dst[4 * (WP / 2)] = (unsigned short)(w2 & 0xffffu); dst[5 * (WP / 2)] = (unsigned short)(w2 >> 16); dst[6 * (WP / 2)] = (unsigned short)(w3 & 0xffffu); dst[7 * (WP / 2)] = (unsigned short)(w3 >> 16); }
        if (un + G < 2048) { const int gn = (un + G) & 7; const size_t tokn = (size_t)((un + G) >> 3) * 128;
#pragma unroll
            for (int i = 0; i < 4; ++i) { const int p = tid + 512 * i, s = p >> 4, seg = p & 15; vreg[i] = *(const u32x4*)(Z + (tokn + s) * ZLD + 1024 + gn * 128 + seg * 8); rvreg[i] = ssv[tokn + s]; } }
        const int tt = 16 * wid + l16; const float bs = b_s[g * 128 + tt];
        const bf16* up = Z + (tok0 + tt) * ZLD + g * 128 + 4 * q4;
        u32x2 ureg[8];
#pragma unroll
        for (int d = 0; d < 8; ++d) ureg[d] = *(const u32x2*)(up + 16 * d);
        __syncthreads();
        pg8::f32x4 acc[8];
#pragma unroll
        for (int d = 0; d < 8; ++d) acc[d] = (pg8::f32x4){0.f, 0.f, 0.f, 0.f};
        const int nsb = (wid >> 1) + 1;
        for (int sb = 0; sb < nsb; ++sb) {
            const bf16x8 wf = *(const LAS bf16x8*)(lds + (16 * wid + l16) * WP + sb * 64 + q4 * 16);
#pragma unroll
            for (int d = 0; d < 8; ++d) { const bf16x8 vf = *(const LAS bf16x8*)(lds + WBYTES + (16 * d + l16) * WP + sb * 64 + q4 * 16); acc[d] = __builtin_amdgcn_mfma_f32_16x16x32_bf16(vf, wf, acc[d], 0, 0, 0); }
        }
        const int t = tt;
        float ss = 0.f;
#pragma unroll
        for (int d = 0; d < 8; ++d) { const u32x2 uu = ureg[d];
            acc[d][0] = bf_lo(uu.x) * (acc[d][0] + bs); acc[d][1] = bf_hi(uu.x) * (acc[d][1] + bs); acc[d][2] = bf_lo(uu.y) * (acc[d][2] + bs); acc[d][3] = bf_hi(uu.y) * (acc[d][3] + bs);
            ss += (acc[d][0] * acc[d][0] + acc[d][1] * acc[d][1]) + (acc[d][2] * acc[d][2] + acc[d][3] * acc[d][3]); }
        ss += __shfl_xor(ss, 16); ss += __shfl_xor(ss, 32);
        const float rn = 1.0f / sqrtf(ss * (1.0f / 128.0f) + EPS);
        bf16* yp = Y + (tok0 + t) * DM + g * 128 + 4 * q4; const float* gp = gout + g * 128 + 4 * q4;
#pragma unroll
        for (int d = 0; d < 8; ++d) { const f32x4 gg = *(const f32x4*)(gp + 16 * d); u32x2 w; w.x = cvt_pk_bf16(acc[d][0] * rn * gg.x, acc[d][1] * rn * gg.y); w.y = cvt_pk_bf16(acc[d][2] * rn * gg.z, acc[d][3] * rn * gg.w);
            *(u32x2*)(yp + 16 * d) = w; }
    }
}
}

constexpr int LDS_BYTES = 147456;
constexpr int NPHASE = 10;
#ifndef DUP_MASK
#define DUP_MASK 0
#endif
struct Args { const float* in[24]; float* out; unsigned char* ws; int ph_lo, ph_hi; };
static_assert(offsetof(Args, out) == 192 && offsetof(Args, ws) == 200, "kernarg offsets");

__global__ void __launch_bounds__(512, 2) fwd_megakernel(Args a) {
    extern __shared__ __attribute__((aligned(16))) unsigned char lds_raw[];
    LAS unsigned char* lds = (LAS unsigned char*)lds_raw;
    cg::grid_group grid = cg::this_grid();
    const int G = gridDim.x, bx = blockIdx.x; const int vcu = (G % 8 == 0) ? (bx % 8) * (G / 8) + bx / 8 : bx;
    const int NGW = G * 8;
    for (int ph = a.ph_lo; ph < a.ph_hi; ++ph) {
    int rep = 0;
phase_again:
    int tid = threadIdx.x; asm volatile("" : "+v"(tid));
    const __attribute__((address_space(4))) char* kp = (const __attribute__((address_space(4))) char*)__builtin_amdgcn_kernarg_segment_ptr(); asm volatile("" : "+s"(kp));
#define KIN(i) (*(const float* const __attribute__((address_space(4)))*)(kp + 8 * (i)))
    unsigned char* ws = *(unsigned char* const __attribute__((address_space(4)))*)(kp + 200); float* out = *(float* const __attribute__((address_space(4)))*)(kp + 192);
    const int lane = tid & 63, wave = __builtin_amdgcn_readfirstlane(tid >> 6), gw = vcu * 8 + wave;
    bf16* XN = (bf16*)(ws + WS_XN); bf16* Yb = (bf16*)(ws + WS_Y); bf16* H = (bf16*)(ws + WS_H); bf16* Z = (bf16*)(ws + WS_Z);
    bf16* QRAW = (bf16*)(ws + WS_QRAW); bf16* KRAW = (bf16*)(ws + WS_KRAW); bf16* VT = (bf16*)(ws + WS_VT); bf16* Qb = (bf16*)(ws + WS_Q); bf16* Kb = (bf16*)(ws + WS_K);
        const bool is_gemm = (ph == 1 || ph == 2 || ph == 3 || ph == 4 || ph == 7 || ph == 8 || ph == 9);
        float* SS = (float*)(ws + WS_SS); bf16* XB1 = (bf16*)out;
        if (is_gemm) {
            const int nsub = (ph == 4) ? 3 : 1;
            for (int sub = 0; sub < nsub; ++sub) {
                pg8::Gemm g; pg8::Epi E; E.mode = 0; E.O = nullptr; E.ldc = 0; E.base = nullptr; E.base_bf = nullptr; E.out = nullptr; E.alpha = 0.f; E.rs = nullptr; E.rs_invn = 1.0f / DM; E.xb = nullptr; E.ss_out = nullptr;
                if (ph == 1) { g = pg8::Gemm{XN, (const bf16*)(ws + WS_WGU1), MTOK, NGU, DM, DM, DM}; E.mode = 2; E.O = H; E.ldc = DFF; }
                else if (ph == 8) { g = pg8::Gemm{(const bf16*)(ws + WS_XB2), (const bf16*)(ws + WS_WGU2), MTOK, NGU, DM, DM, DM}; E.mode = 2; E.O = H; E.ldc = DFF; E.rs = SS + MTOK; }
                else if (ph == 2) { g = pg8::Gemm{H, (const bf16*)(ws + WS_WD1), MTOK, DM, DFF, DFF, DFF}; E.mode = 3; E.base = KIN(0); E.ldc = DM; E.alpha = 0.5f; E.xb = XB1; E.ss_out = SS; }
                else if (ph == 9) { g = pg8::Gemm{H, (const bf16*)(ws + WS_WD2), MTOK, DM, DFF, DFF, DFF}; E.mode = 3; E.base_bf = (const bf16*)(ws + WS_XB2); E.out = out; E.ldc = DM; E.alpha = 0.5f; }
                else if (ph == 3) { g = pg8::Gemm{XB1, (const bf16*)(ws + WS_WIN), MTOK, ZLD, DM, DM, DM}; E.mode = 1; E.O = Z; E.ldc = ZLD; E.rs = SS; E.ss_out = SS + 2 * MTOK; }
                else if (ph == 7) { g = pg8::Gemm{Yb, (const bf16*)(ws + WS_WOUT), MTOK, DM, DM, DM, DM}; E.mode = 3; E.base_bf = XB1; E.ldc = DM; E.alpha = 1.0f; E.xb = (bf16*)(ws + WS_XB2); E.ss_out = SS + MTOK; }
                else if (sub == 0) { g = pg8::Gemm{Z + 2048, (const bf16*)(ws + WS_WQ), MTOK, QW, 512, ZLD, 512}; E.O = QRAW; E.ldc = QW; E.rs = SS + 3 * MTOK; E.rs_invn = 1.0f / 512.0f; }
                else if (sub == 1) { g = pg8::Gemm{Z + 2560, (const bf16*)(ws + WS_WK), MTOK, 1024, 512, ZLD, 512}; E.O = KRAW; E.ldc = 1024; E.rs = SS + 4 * MTOK; E.rs_invn = 1.0f / 512.0f; }
                else { g = pg8::Gemm{(const bf16*)(ws + WS_WV), Z + 2560, 1024, MTOK, 512, 512, ZLD}; E.mode = 4; E.O = VT; E.ldc = MTOK; E.rs = SS + 4 * MTOK; E.rs_invn = 1.0f / 512.0f; }
                pg8::StaticOrder S; S.init(g.M, g.N, G, bx, (ph == 2 || ph == 7 || ph == 9) ? 4 : 8);
#ifndef NO_GEMM
                pg8::gemm_phase(lds, g, S, E, tid);
#endif
            }
#ifndef NO_GM
            if (ph == 4) gm::gmlp_phase(lds, Z, KIN(9), KIN(10), KIN(17), SS + 2 * MTOK, KIN(8), Yb, vcu, G, tid);
#endif
        } else if (ph == 0) {
            p0_weights(lds, ws, KIN(3), KIN(4), KIN(5), KIN(21), KIN(22), KIN(23), KIN(7), KIN(12), KIN(14), KIN(19), KIN(6), KIN(20), KIN(11), KIN(13), gw, NGW, wave, lane);
            for (int m = gw; m < MTOK; m += NGW) rms_row_to_bf16(KIN(0) + (size_t)m * DM, KIN(2), XN + (size_t)m * DM, lane);
        } else if (ph == 5) {
            for (int m = gw; m < MTOK; m += 2 * NGW) qk_token2(m, (m + NGW < MTOK) ? m + NGW : m, (const int*)KIN(1), QRAW, KRAW, Z, KIN(15), KIN(16), Qb, Kb, lane);
        } else if (ph == 6) {
            for (int v = vcu; v < 256; v += G) { const int bh = v >> 1, s0 = (v & 1) * 2;
#pragma unroll 1
                for (int i = 0; i < 4; ++i) { const int qb = (i == 0) ? 7 - s0 : (i == 1) ? s0 : (i == 2) ? 6 - s0 : s0 + 1;
#ifndef NO_ATT
                    att::attn_unit(lds, Qb, Kb, VT, Yb, KIN(18), bh >> 3, bh & 7, qb, tid);
#endif
                } }
        }
        if (ph + 1 < a.ph_hi) grid.sync();
#if DUP_MASK
        if (((DUP_MASK >> ph) & 1) && rep == 0) { rep = 1; if (ph + 1 >= a.ph_hi) grid.sync(); goto phase_again; }
#endif
    }
}

extern "C" void kernel_launch(void* const* d_in, const int* in_sizes, int n_in, void* d_out, int out_size, void* d_ws, size_t ws_size, hipStream_t stream) {
    static int grid = 0;
    if (grid == 0) {
        if (n_in != 24 || out_size != MTOK * DM || ws_size < WS_END) { fprintf(stderr, "kernel_launch: unexpected problem (n_in %d, out %d, ws %zu); nothing launched\n", n_in, out_size, ws_size); grid = -1; return; }
        int dev = 0, cus = 0, per_cu = 0;
        if (hipGetDevice(&dev) != hipSuccess || hipDeviceGetAttribute(&cus, hipDeviceAttributeMultiprocessorCount, dev) != hipSuccess) { grid = -1; return; }
        if (hipFuncSetAttribute((const void*)fwd_megakernel, hipFuncAttributeMaxDynamicSharedMemorySize, LDS_BYTES) != hipSuccess) { fprintf(stderr, "kernel_launch: hipFuncSetAttribute failed\n"); grid = -1; return; }
        if (hipOccupancyMaxActiveBlocksPerMultiprocessor(&per_cu, (const void*)fwd_megakernel, 512, LDS_BYTES) != hipSuccess || per_cu < 1) { fprintf(stderr, "kernel_launch: occupancy query says %d\n", per_cu); per_cu = 1; }
        (void)hipGetLastError();
        grid = cus * per_cu;
        if (grid % 8 != 0 || grid > 2048) grid = cus;
    }
    if (grid < 0) return;
    Args a{};
    for (int i = 0; i < 24; ++i) a.in[i] = (const float*)d_in[i];
    a.out = (float*)d_out; a.ws = (unsigned char*)d_ws;
#if MK_MULTI
    for (int ph = 0; ph < NPHASE; ++ph) { a.ph_lo = ph; a.ph_hi = ph + 1; hipLaunchKernelGGL(fwd_megakernel, dim3(grid), dim3(512), LDS_BYTES, stream, a); }
#else
    a.ph_lo = 0; a.ph_hi = NPHASE;
    void* args[] = {&a};
    hipError_t e = hipLaunchCooperativeKernel((const void*)fwd_megakernel, dim3(grid), dim3(512), args, LDS_BYTES, stream);
    if (e != hipSuccess) fprintf(stderr, "kernel_launch: cooperative launch failed: %s (grid %d)\n", hipGetErrorString(e), grid);
#endif
}
```

```cpp
#include <hip/hip_runtime.h>
#include <hip/hip_cooperative_groups.h>
#include <cstdio>
#include <cstdint>
#include <cstddef>
namespace cg = cooperative_groups;

#ifndef MK_MULTI
#define MK_MULTI 0
#endif

constexpr int BATCH = 16, SEQ = 2048, DM = 2048, MTOK = BATCH * SEQ, DFF = 5504, NGU = 2 * DFF;
constexpr int ZLD = 3328;
constexpr int NH = 8, QKD = 192, VD = 128, QW = NH * QKD  ;
constexpr float EPS = 1e-6f;

namespace pg8 {
#define PG8_LAS __attribute__((address_space(3)))
typedef unsigned short bf16_t;
typedef short bf16x8 __attribute__((ext_vector_type(8)));
typedef float f32x4 __attribute__((ext_vector_type(4)));
typedef float f32x2 __attribute__((ext_vector_type(2)));
typedef unsigned u32x4 __attribute__((ext_vector_type(4)));
typedef unsigned u32x2 __attribute__((ext_vector_type(2)));
typedef __bf16 bf16x2_t __attribute__((ext_vector_type(2)));
constexpr int BM = 256, BK = 64, HALF = 128, HTB = HALF * BK * 2  , STAGE_BYTES = 8 * HTB, NXCD = 8, WGM = 8;

__host__ __device__ __forceinline__ int lds_byte(int r, int c) { const int st = (r >> 4) * 2 + (c >> 5), rr = r & 15, cc = c & 31, ob = rr * 64 + cc * 2; return st * 1024 + (ob ^ (((ob >> 9) & 1) << 5)); }
__host__ __device__ __forceinline__ void stage_rc(int b, int& R, int& C) { const int st = b / 1024, sb = b % 1024, swz = sb ^ (((sb >> 9) & 1) << 5); R = (st >> 1) * 16 + swz / 64; C = (st & 1) * 32 + (swz % 64) / 2; }
__host__ __device__ __forceinline__ int perm32(int rho) { const int n = rho >> 4, i = rho & 15; return 8 * (i >> 2) + 4 * n + (i & 3); }

struct Unit { int pm, pn; };
struct Gemm { const bf16_t* A; const bf16_t* Bt; int M, N, K, lda, ldb; };

struct StaticOrder {
    int nM, nN, nwg, G, c, wgm;
    __host__ __device__ void init(int M, int N, int G_, int c_, int wgm_) { nM = M / BM; nN = N / BM; nwg = nM * nN; G = G_; c = c_; wgm = wgm_; }
    __host__ __device__ bool next(int i, Unit& u) const {
        const long L = (long)i * G + c; if (L >= nwg) return false;
        int wgid = (int)L; { const int q = nwg / NXCD, r = nwg % NXCD, xcd = wgid % NXCD, off = wgid / NXCD; wgid = (xcd < r ? xcd * (q + 1) : r * (q + 1) + (xcd - r) * q) + off; }
        const int nig = wgm * nN, gid = wgid / nig, fm = gid * wgm, gsz = (nM - fm) < wgm ? (nM - fm) : wgm;
        u.pm = fm + ((wgid % nig) % gsz); u.pn = (wgid % nig) / gsz; return true;
    }
};

__device__ __forceinline__ unsigned cvt_pk_bf16(float lo, float hi) { f32x2 v = {lo, hi}; bf16x2_t b = __builtin_convertvector(v, bf16x2_t); return __builtin_bit_cast(unsigned, b); }
__device__ __forceinline__ f32x2 gelu_pk(f32x2 v) {
    const f32x2 av = __builtin_elementwise_abs(v), d = av * 0.2316418882f + 1.0f;
    f32x2 t; t.x = __builtin_amdgcn_rcpf(d.x); t.y = __builtin_amdgcn_rcpf(d.y);
    f32x2 q = t * 0.5307027145f + (-0.7265760135f); q = q * t + 0.7107068705f; q = q * t + (-0.142248368f); q = q * t + 0.127414796f; q = q * t;
    const f32x2 s = (v * v) * (-0.72134752044f);
    f32x2 e; e.x = __builtin_amdgcn_exp2f(s.x); e.y = __builtin_amdgcn_exp2f(s.y);
    const f32x2 m = v * (q * e), r = v - m;
    f32x2 o; o.x = v.x < 0.f ? m.x : r.x; o.y = v.y < 0.f ? m.y : r.y; return o;
}
__device__ __forceinline__ f32x4 gelu4(f32x4 v) { f32x2 a = gelu_pk((f32x2){v[0], v[1]}), b = gelu_pk((f32x2){v[2], v[3]}); return (f32x4){a.x, a.y, b.x, b.y}; }
__device__ __forceinline__ float silu_mul(float g, float u) { return g * u * __builtin_amdgcn_rcpf(1.0f + __builtin_amdgcn_exp2f(-1.4426950408889634f * g)); }

struct Epi {
    int mode; bf16_t* O; int ldc; const float* base; const bf16_t* base_bf; float* out; float alpha; const float* rs; float rs_invn; bf16_t* xb; float* ss_out;
    __device__ __forceinline__ void operator()(const f32x4 (&acc)[2][2][4][2], const Unit& u, int wr, int wc, int fr, int fq) const {
        const int row0 = u.pm * BM + wr * 64 + fr;
#ifdef FORCE_MODE
        const int mode = FORCE_MODE;
#endif
        if (mode == 3) {
            const int col0 = u.pn * BM + wc * 32 + 8 * fq;
#pragma unroll
            for (int ai = 0; ai < 2; ++ai)
#pragma unroll
                for (int m = 0; m < 4; ++m) { const int row = row0 + ai * HALF + m * 16; const size_t off = (size_t)row * ldc + col0; float ssr = 0.f;
#pragma unroll
                    for (int bj = 0; bj < 2; ++bj) { f32x4 b0, b1;
                        if (base_bf) { const u32x4 t = *(const u32x4*)(base_bf + off + bj * HALF);
                            b0 = (f32x4){__uint_as_float(t.x << 16), __uint_as_float(t.x & 0xffff0000u), __uint_as_float(t.y << 16), __uint_as_float(t.y & 0xffff0000u)};
                            b1 = (f32x4){__uint_as_float(t.z << 16), __uint_as_float(t.z & 0xffff0000u), __uint_as_float(t.w << 16), __uint_as_float(t.w & 0xffff0000u)}; }
                        else { b0 = *(const f32x4*)(base + off + bj * HALF); b1 = *(const f32x4*)(base + off + bj * HALF + 4); }
                        const f32x4 o0 = b0 + acc[ai][bj][m][0] * alpha, o1 = b1 + acc[ai][bj][m][1] * alpha;
                        if (out) { *(f32x4*)(out + off + bj * HALF) = o0; *(f32x4*)(out + off + bj * HALF + 4) = o1; }
                        if (xb) { ssr += (o0[0] * o0[0] + o0[1] * o0[1]) + (o0[2] * o0[2] + o0[3] * o0[3]) + (o1[0] * o1[0] + o1[1] * o1[1]) + (o1[2] * o1[2] + o1[3] * o1[3]);
                            u32x4 w; w.x = cvt_pk_bf16(o0[0], o0[1]); w.y = cvt_pk_bf16(o0[2], o0[3]); w.z = cvt_pk_bf16(o1[0], o1[1]); w.w = cvt_pk_bf16(o1[2], o1[3]); *(u32x4*)(xb + off + bj * HALF) = w; } }
                    if (xb) { ssr += __shfl_xor(ssr, 16); ssr += __shfl_xor(ssr, 32); if (fq == 0) atomicAdd(ss_out + row, ssr); }
                    if (m == 3) asm volatile("" ::: "memory"); }
            return;
        }
        f32x4 cs[2][2];
#pragma unroll
        for (int bj = 0; bj < 2; ++bj)
#pragma unroll
            for (int n = 0; n < 2; ++n) cs[bj][n] = (f32x4){1.f, 1.f, 1.f, 1.f};
        if (mode == 4) {
            const int c0 = u.pn * BM + wc * 32 + 8 * fq;
#pragma unroll
            for (int bj = 0; bj < 2; ++bj)
#pragma unroll
                for (int n = 0; n < 2; ++n) { const f32x4 s = *(const f32x4*)(rs + c0 + bj * HALF + 4 * n);
#pragma unroll
                    for (int i = 0; i < 4; ++i) cs[bj][n][i] = __builtin_amdgcn_rsqf(s[i] * rs_invn + 1e-6f); }
        }
        const bool rowscale = (rs != nullptr) && (mode != 4);
        const bool act = (mode == 1) && (u.pn < 8), stat = (mode == 1) && (u.pn >= 4) && (u.pn < 12);
        float* ssp = ss_out + (u.pn < 8 ? 0 : (u.pn < 10 ? 32768 : 65536));
        const int col0 = (mode == 2 ? u.pn * HALF : u.pn * BM) + wc * 32 + 8 * fq;
#pragma unroll
        for (int ai = 0; ai < 2; ++ai)
#pragma unroll
            for (int m = 0; m < 4; ++m) { const int row = row0 + ai * HALF + m * 16; bf16_t* rowp = O + (size_t)row * ldc + col0;
                float r = 1.0f; if (rowscale) r = __builtin_amdgcn_rsqf(rs[row] * rs_invn + 1e-6f);
                if (mode == 2) {
                    const f32x4 g0 = acc[ai][0][m][0] * r, g1 = acc[ai][0][m][1] * r, u0 = acc[ai][1][m][0] * r, u1 = acc[ai][1][m][1] * r;
                    u32x4 w; w.x = cvt_pk_bf16(silu_mul(g0[0], u0[0]), silu_mul(g0[1], u0[1])); w.y = cvt_pk_bf16(silu_mul(g0[2], u0[2]), silu_mul(g0[3], u0[3]));
                    w.z = cvt_pk_bf16(silu_mul(g1[0], u1[0]), silu_mul(g1[1], u1[1])); w.w = cvt_pk_bf16(silu_mul(g1[2], u1[2]), silu_mul(g1[3], u1[3]));
                    *(u32x4*)rowp = w;
                } else {
                    float ssr = 0.f;
#pragma unroll
                    for (int bj = 0; bj < 2; ++bj) { f32x4 v0 = acc[ai][bj][m][0] * cs[bj][0] * r, v1 = acc[ai][bj][m][1] * cs[bj][1] * r;
                        if (act) { v0 = gelu4(v0); v1 = gelu4(v1); }
                        ssr += (v0[0] * v0[0] + v0[1] * v0[1]) + (v0[2] * v0[2] + v0[3] * v0[3]) + (v1[0] * v1[0] + v1[1] * v1[1]) + (v1[2] * v1[2] + v1[3] * v1[3]);
                        u32x4 w; w.x = cvt_pk_bf16(v0[0], v0[1]); w.y = cvt_pk_bf16(v0[2], v0[3]); w.z = cvt_pk_bf16(v1[0], v1[1]); w.w = cvt_pk_bf16(v1[2], v1[3]);
                        *(u32x4*)(rowp + bj * HALF) = w; }
                    if (stat) { ssr += __shfl_xor(ssr, 16); ssr += __shfl_xor(ssr, 32); if (fq == 0) atomicAdd(ssp + row, ssr); }
                }
            }
    }
};

__device__ __forceinline__ void gemm_phase(PG8_LAS unsigned char* lds, const Gemm g, const StaticOrder& S, const Epi& E, const int tid) {
    const int wid = __builtin_amdgcn_readfirstlane(tid >> 6), lane = tid & 63, wr = wid >> 2, wc = wid & 3, fr = lane & 15, fq = lane >> 4;
    const int K = g.K, nt = K / BK;
    unsigned voffA[2], voffB[2];
#pragma unroll
    for (int i = 0; i < 2; ++i) { int R, C; stage_rc(tid * 16 + i * 8192, R, C); const int Rb = (R & ~31) + perm32(R & 31);
        voffA[i] = (unsigned)(R * g.lda + C) * 2u; voffB[i] = (unsigned)(Rb * g.ldb + C) * 2u; }
    const size_t kstep = (size_t)(BK * 2);
    const size_t hstepA = (size_t)HALF * g.lda * 2, hstepB = (size_t)HALF * g.ldb * 2;
    const size_t tstepA = 2 * hstepA, tstepB = 2 * hstepB;
    const unsigned ldsw = (unsigned)wid * 1024u;
    const int aoff = lds_byte(wr * 64 + fr, fq * 8), boff = lds_byte(wc * 32 + fr, fq * 8);
#define PG8_SA(b, h) (((b) * 2 + (h)) * HTB)
#define PG8_SB(b, h) ((4 + (b) * 2 + (h)) * HTB)
#define PG8_STAGE(bufoff, gbase, voff) do { _Pragma("unroll") for (int _i = 0; _i < 2; ++_i) \
        __builtin_amdgcn_global_load_lds((const unsigned*)((const char*)(gbase) + (voff)[_i]), (PG8_LAS unsigned*)(lds + (bufoff) + ldsw + _i * 8192), 16, 0, 0); } while (0)
#define PG8_LDA(dst, b, h) do { _Pragma("unroll") for (int m = 0; m < 4; ++m) _Pragma("unroll") for (int k = 0; k < 2; ++k) dst[m][k] = *(const PG8_LAS bf16x8*)(lds + PG8_SA(b, h) + aoff + m * 2048 + k * 1024); } while (0)
#define PG8_LDB(dst, b, h) do { _Pragma("unroll") for (int n = 0; n < 2; ++n) _Pragma("unroll") for (int k = 0; k < 2; ++k) dst[n][k] = *(const PG8_LAS bf16x8*)(lds + PG8_SB(b, h) + boff + n * 2048 + k * 1024); } while (0)
#define PG8_MMA(ai, bj, At, Bt) do { __builtin_amdgcn_s_setprio(1); _Pragma("unroll") for (int m = 0; m < 4; ++m) _Pragma("unroll") for (int n = 0; n < 2; ++n) _Pragma("unroll") for (int k = 0; k < 2; ++k) \
        acc[ai][bj][m][n] = __builtin_amdgcn_mfma_f32_16x16x32_bf16(Bt[n][k], At[m][k], acc[ai][bj][m][n], 0, 0, 0); __builtin_amdgcn_s_setprio(0); } while (0)
#define PG8_WAIT_V(n) asm volatile("s_waitcnt vmcnt(" #n ")" ::: "memory")
#define PG8_WAIT_L(n) asm volatile("s_waitcnt lgkmcnt(" #n ")" ::: "memory")
#define PG8_BAR __builtin_amdgcn_s_barrier()
#define PG8_SCHED __builtin_amdgcn_sched_barrier(0)
    Unit cur, nxt; int ui = 0;
    if (!S.next(0, cur)) return;
    f32x4 acc[2][2][4][2];
#pragma unroll
    for (int a = 0; a < 2; ++a)
#pragma unroll
        for (int b = 0; b < 2; ++b)
#pragma unroll
            for (int m = 0; m < 4; ++m)
#pragma unroll
                for (int n = 0; n < 2; ++n) acc[a][b][m][n] = (f32x4){0.f, 0.f, 0.f, 0.f};
    bf16x8 At[4][2], B0[2][2], B1[2][2];
    const char* cA = (const char*)g.A + (size_t)cur.pm * tstepA; const char* cB = (const char*)g.Bt + (size_t)cur.pn * tstepB;
    PG8_STAGE(PG8_SB(0, 0), cB, voffB); PG8_STAGE(PG8_SB(0, 1), cB + hstepB, voffB); PG8_STAGE(PG8_SA(0, 0), cA, voffA); PG8_STAGE(PG8_SA(0, 1), cA + hstepA, voffA);
    if (wr == 1) PG8_BAR;
    PG8_WAIT_V(2); PG8_BAR;
    PG8_STAGE(PG8_SB(1, 0), cB + kstep, voffB); PG8_STAGE(PG8_SA(1, 0), cA + kstep, voffA); PG8_STAGE(PG8_SB(1, 1), cB + hstepB + kstep, voffB);
    PG8_WAIT_V(6); PG8_BAR;
    for (;;) {
        const bool has_next = S.next(ui + 1, nxt);
        const char* nA = has_next ? (const char*)g.A + (size_t)nxt.pm * tstepA : cA; const char* nB = has_next ? (const char*)g.Bt + (size_t)nxt.pn * tstepB : cB;
        for (int t = 0; t < nt; t += 2) {
            const bool last = (t == nt - 2);
            const char* a1 = cA + (size_t)(t + 1) * kstep;
            const char* a2 = last ? nA : cA + (size_t)(t + 2) * kstep; const char* b2 = last ? nB : cB + (size_t)(t + 2) * kstep;
            const char* a3 = a2 + kstep; const char* b3 = b2 + kstep;
            PG8_LDB(B0, 0, 0); PG8_LDB(B1, 0, 1); PG8_SCHED; PG8_LDA(At, 0, 0); PG8_STAGE(PG8_SA(1, 1), a1 + hstepA, voffA);
            PG8_WAIT_V(8); PG8_WAIT_L(0); PG8_BAR; PG8_MMA(0, 0, At, B0); PG8_MMA(0, 1, At, B1); PG8_BAR; PG8_SCHED;
            PG8_LDA(At, 0, 1); PG8_STAGE(PG8_SB(0, 0), b2, voffB); PG8_STAGE(PG8_SB(0, 1), b2 + hstepB, voffB); PG8_STAGE(PG8_SA(0, 0), a2, voffA);
            PG8_WAIT_V(8); PG8_WAIT_L(0); PG8_BAR; PG8_MMA(1, 0, At, B0); PG8_MMA(1, 1, At, B1); PG8_BAR; PG8_SCHED;
            PG8_LDB(B0, 1, 0); PG8_LDB(B1, 1, 1); PG8_SCHED; PG8_LDA(At, 1, 0); PG8_STAGE(PG8_SA(0, 1), a2 + hstepA, voffA);
            PG8_WAIT_V(8); PG8_WAIT_L(0); PG8_BAR; PG8_MMA(0, 0, At, B0); PG8_MMA(0, 1, At, B1); PG8_BAR; PG8_SCHED;
            PG8_LDA(At, 1, 1); PG8_STAGE(PG8_SB(1, 0), b3, voffB); PG8_STAGE(PG8_SB(1, 1), b3 + hstepB, voffB); PG8_STAGE(PG8_SA(1, 0), a3, voffA);
            PG8_WAIT_V(8); PG8_WAIT_L(0); PG8_BAR; PG8_MMA(1, 0, At, B0); PG8_MMA(1, 1, At, B1); PG8_BAR; PG8_SCHED;
        }
        if (wr == 0) PG8_BAR;
        E(acc, cur, wr, wc, fr, fq);
        if (!has_next) break;
#pragma unroll
        for (int a = 0; a < 2; ++a)
#pragma unroll
            for (int b = 0; b < 2; ++b)
#pragma unroll
                for (int m = 0; m < 4; ++m)
#pragma unroll
                    for (int n = 0; n < 2; ++n) acc[a][b][m][n] = (f32x4){0.f, 0.f, 0.f, 0.f};
        cur = nxt; cA = nA; cB = nB; ++ui;
        if (wr == 1) PG8_BAR;
    }
    PG8_WAIT_V(0);
    PG8_BAR;
#undef PG8_SA
#undef PG8_SB
#undef PG8_STAGE
#undef PG8_LDA
#undef PG8_LDB
#undef PG8_MMA
#undef PG8_WAIT_V
#undef PG8_WAIT_L
#undef PG8_BAR
#undef PG8_SCHED
}
}

#define LAS __attribute__((address_space(3)))
typedef unsigned short bf16;
typedef float f32x4 __attribute__((ext_vector_type(4)));
typedef float f32x16 __attribute__((ext_vector_type(16)));
typedef short bf16x8 __attribute__((ext_vector_type(8)));
typedef unsigned u32x4 __attribute__((ext_vector_type(4)));
typedef unsigned u32x2 __attribute__((ext_vector_type(2)));
using pg8::cvt_pk_bf16;
__device__ __forceinline__ float bf_lo(unsigned u) { return __uint_as_float(u << 16); }
__device__ __forceinline__ float bf_hi(unsigned u) { return __uint_as_float(u & 0xffff0000u); }
__device__ __forceinline__ float wave_sum(float v) {
#pragma unroll
    for (int o = 1; o < 64; o <<= 1) v += __shfl_xor(v, o);
    return v;
}

constexpr size_t MiB = 1u << 20;
constexpr size_t WS_WGU1 = 2 * MiB, WS_WD1 = 46 * MiB, WS_WGU2 = 68 * MiB, WS_WD2 = 112 * MiB, WS_WIN = 134 * MiB, WS_WQ = 147 * MiB + MiB / 2, WS_WK = 149 * MiB, WS_WV = 150 * MiB, WS_WOUT = 151 * MiB;
constexpr size_t WS_BAR = 1 * MiB;
constexpr size_t WS_SS = 0;
constexpr size_t WS_XB2 = 632 * MiB;
constexpr size_t WS_XN = 160 * MiB;
constexpr size_t WS_Y = WS_XN;
constexpr size_t WS_H = 288 * MiB;
constexpr size_t WS_Z = 288 * MiB;
constexpr size_t WS_QRAW = 496 * MiB;
constexpr size_t WS_KRAW = 632 * MiB;
constexpr size_t WS_VT = 696 * MiB;
constexpr int VT_LD = MTOK + 64;
constexpr size_t WS_Q = 761 * MiB;
constexpr size_t WS_K = 857 * MiB;
constexpr size_t WS_END = 953 * MiB;
static_assert(WS_WGU1 + (size_t)NGU * DM * 2 <= WS_WD1 && WS_WD1 + (size_t)DM * DFF * 2 <= WS_WGU2 && WS_WGU2 + (size_t)NGU * DM * 2 <= WS_WD2 && WS_WD2 + (size_t)DM * DFF * 2 <= WS_WIN, "ws map 1");
static_assert(WS_WIN + (size_t)ZLD * DM * 2 <= WS_WQ && WS_WQ + (size_t)QW * 512 * 2 <= WS_WK && WS_WK + 1024 * 512 * 2 <= WS_WV && WS_WV + 1024 * 512 * 2 <= WS_WOUT && WS_WOUT + (size_t)DM * DM * 2 <= WS_XN, "ws map 2");
static_assert(WS_XN + (size_t)MTOK * DM * 2 <= WS_H && WS_H + (size_t)MTOK * DFF * 2 <= WS_KRAW && WS_Z + (size_t)MTOK * ZLD * 2 <= WS_QRAW && WS_QRAW + (size_t)MTOK * QW * 2 <= WS_KRAW, "ws map 3");
static_assert(WS_KRAW + (size_t)MTOK * 1024 * 2 <= WS_VT && WS_VT + (size_t)VT_LD * 1024 * 2 <= WS_Q && WS_Q + (size_t)MTOK * QW * 2 <= WS_K && WS_K + (size_t)MTOK * QW * 2 <= WS_END, "ws map 4");

__device__ __forceinline__ unsigned f2bf(float f) { unsigned u = __builtin_bit_cast(unsigned, f); return (u + 0x7fffu + ((u >> 16) & 1u)) >> 16; }
__device__ __forceinline__ unsigned pk2(float lo, float hi) { return f2bf(lo) | (f2bf(hi) << 16); }
__device__ __forceinline__ void transpose_item(const float* W, int N, bf16* dst  , int K, int k0, int n0, LAS float* scr, int lane, const float* gk  ) {
    float wv[32];
#pragma unroll
    for (int i = 0; i < 32; ++i) { const int kk = 2 * i + (lane >> 5); wv[i] = W[(size_t)(k0 + kk) * N + n0 + (lane & 31)]; }
    if (gk) {
#pragma unroll
        for (int i = 0; i < 32; ++i) wv[i] *= gk[k0 + 2 * i + (lane >> 5)];
    }
#pragma unroll
    for (int i = 0; i < 32; ++i) { const int kk = 2 * i + (lane >> 5); scr[kk * 33 + (lane & 31)] = wv[i]; }
    asm volatile("s_waitcnt lgkmcnt(0)" ::: "memory");
    const int c = lane & 7;
#pragma unroll
    for (int j = 0; j < 4; ++j) { const int n = (lane >> 3) + 8 * j; const LAS float* s = scr + (8 * c) * 33 + n;
        u32x4 o; o.x = pk2(s[0 * 33], s[1 * 33]); o.y = pk2(s[2 * 33], s[3 * 33]); o.z = pk2(s[4 * 33], s[5 * 33]); o.w = pk2(s[6 * 33], s[7 * 33]);
        *(u32x4*)(dst + (size_t)n * K + k0 + 8 * c) = o; }
    asm volatile("s_waitcnt lgkmcnt(0)" ::: "memory");
}
__device__ __forceinline__ void rms_row_to_bf16(const float* xrow, const float* g, bf16* orow, int lane) {
    const f32x4* xr = (const f32x4*)xrow + lane; const f32x4* gr = (const f32x4*)g + lane;
    f32x4 v[8]; float s = 0.f;
#pragma unroll
    for (int j = 0; j < 8; ++j) { v[j] = xr[64 * j]; s += (v[j].x * v[j].x + v[j].y * v[j].y) + (v[j].z * v[j].z + v[j].w * v[j].w); }
    const float r = 1.0f / sqrtf(wave_sum(s) * (1.0f / DM) + EPS);
    u32x2* o8 = (u32x2*)orow + lane;
#pragma unroll
    for (int j = 0; j < 8; ++j) { const f32x4 gg = gr[64 * j]; u32x2 w; w.x = cvt_pk_bf16(v[j].x * r * gg.x, v[j].y * r * gg.y); w.y = cvt_pk_bf16(v[j].z * r * gg.z, v[j].w * r * gg.w); o8[64 * j] = w; }
}

__device__ __forceinline__ void p0_weights(LAS unsigned char* lds, unsigned char* ws, const float* wg1, const float* wu1, const float* wd1, const float* wg2, const float* wu2, const float* wd2,
                                           const float* win, const float* wq, const float* wkv, const float* wout, const float* g_mix, const float* g_ffn2, const float* g_q, const float* g_kv, int gw, int NGW, int wave, int lane) {
    LAS float* scr = (LAS float*)(lds + wave * 8448);
    constexpr int I_F = (DM / 64) * (DFF / 32);
    constexpr int I_IN = (DM / 64) * (3136 / 32), I_Q = (512 / 64) * (QW / 32), I_KV = (512 / 64) * (2048 / 32), I_O = (DM / 64) * (DM / 32);
    constexpr int NITEMS = 6 * I_F + I_IN + I_Q + I_KV + I_O;
    for (int it = gw; it < NITEMS; it += NGW) {
        int r = it;
        if (r < 6 * I_F) {
            const int which = r / I_F; r -= which * I_F; const int ffn = which / 3, kind = which % 3;
            if (kind < 2) { const float* W = wg1; if (which == 1) W = wu1; if (which == 3) W = wg2; if (which == 4) W = wu2; bf16* D = (bf16*)(ws + (ffn ? WS_WGU2 : WS_WGU1));
                const int nblk = DFF / 32, kb = r / nblk, nb = r % nblk, n0 = nb * 32; const int drow = (n0 / 128) * 256 + (n0 % 128) + kind * 128;
                transpose_item(W, DFF, D + (size_t)drow * DM, DM, kb * 64, n0, scr, lane, ffn ? g_ffn2 : nullptr); }
            else { const float* W = wd1; if (ffn) W = wd2; bf16* D = (bf16*)(ws + (ffn ? WS_WD2 : WS_WD1));
                const int nblk = DM / 32, kb = r / nblk, nb = r % nblk, n0 = nb * 32;
                transpose_item(W, DM, D + (size_t)n0 * DFF, DFF, kb * 64, n0, scr, lane, nullptr); }
            continue;
        }
        r -= 6 * I_F;
        if (r < I_IN) { const int nblk = 3136 / 32, kb = r / nblk, nb = r % nblk, n0 = nb * 32; transpose_item(win, 3136, (bf16*)(ws + WS_WIN) + (size_t)n0 * DM, DM, kb * 64, n0, scr, lane, g_mix); continue; }
        r -= I_IN;
        if (r < I_Q) { const int nblk = QW / 32, kb = r / nblk, nb = r % nblk, n0 = nb * 32; transpose_item(wq, QW, (bf16*)(ws + WS_WQ) + (size_t)n0 * 512, 512, kb * 64, n0, scr, lane, g_q); continue; }
        r -= I_Q;
        if (r < I_KV) { const int nblk = 2048 / 32, kb = r / nblk, nb = r % nblk, n0 = nb * 32; const int h = n0 >> 8, c = n0 & 255;
            bf16* D = (c < 128) ? (bf16*)(ws + WS_WK) + (size_t)(h * 128 + c) * 512 : (bf16*)(ws + WS_WV) + (size_t)(h * 128 + c - 128) * 512;
            transpose_item(wkv, 2048, D, 512, kb * 64, n0, scr, lane, g_kv); continue; }
        r -= I_KV;
        { const int nblk = DM / 32, kb = r / nblk, nb = r % nblk, n0 = nb * 32; transpose_item(wout, DM, (bf16*)(ws + WS_WOUT) + (size_t)n0 * DM, DM, kb * 64, n0, scr, lane, nullptr); }
    }
    { float* ssz = (float*)(ws + WS_SS); for (int i = gw * 64 + lane; i < 5 * MTOK; i += NGW * 64) ssz[i] = 0.f; }
    { u32x4* z = (u32x4*)((bf16*)(ws + WS_WIN) + (size_t)3136 * DM); const int n16 = (ZLD - 3136) * DM * 2 / 16;
      for (int i = gw * 64 + lane; i < n16; i += NGW * 64) z[i] = (u32x4){0u, 0u, 0u, 0u}; }
}

__device__ __forceinline__ void znorm_seg16(bf16* p, const float* g, float invn, int lane, int nvec  ) {
    u32x4 a[2]; float s = 0.f;
#pragma unroll
    for (int j = 0; j < 2; ++j) if (j < nvec) { a[j] = *(const u32x4*)(p + j * 512 + lane * 8);
#pragma unroll
        for (int k = 0; k < 4; ++k) { const float lo = bf_lo(a[j][k]), hi = bf_hi(a[j][k]); s += lo * lo + hi * hi; } }
    const float r = 1.0f / sqrtf(wave_sum(s) * invn + EPS);
#pragma unroll
    for (int j = 0; j < 2; ++j) if (j < nvec) { const f32x4 g0 = *(const f32x4*)(g + j * 512 + lane * 8), g1 = *(const f32x4*)(g + j * 512 + lane * 8 + 4); u32x4 w;
        w.x = cvt_pk_bf16(bf_lo(a[j].x) * r * g0.x, bf_hi(a[j].x) * r * g0.y); w.y = cvt_pk_bf16(bf_lo(a[j].y) * r * g0.z, bf_hi(a[j].y) * r * g0.w);
        w.z = cvt_pk_bf16(bf_lo(a[j].z) * r * g1.x, bf_hi(a[j].z) * r * g1.y); w.w = cvt_pk_bf16(bf_lo(a[j].w) * r * g1.z, bf_hi(a[j].w) * r * g1.w);
        *(u32x4*)(p + j * 512 + lane * 8) = w; }
}

__device__ const double ROPE_REV[32] = {0.15915494309189535, 0.11934937021124886, 0.08949940160889101, 0.06711508300522726, 0.050329212104487035, 0.03774158471741977, 0.0283021958306234, 0.02122365276477766,
    0.015915494309189534, 0.011934937021124886, 0.008949940160889102, 0.006711508300522725, 0.005032921210448704, 0.003774158471741977, 0.00283021958306234, 0.0021223652764777662,
    0.0015915494309189536, 0.0011934937021124885, 0.0008949940160889102, 0.0006711508300522726, 0.0005032921210448703, 0.00037741584717419774, 0.00028302195830623395, 0.0002122365276477766,
    0.00015915494309189535, 0.00011934937021124886, 8.949940160889102e-05, 6.711508300522725e-05, 5.0329212104487035e-05, 3.774158471741978e-05, 2.8302195830623396e-05, 2.122365276477766e-05};
constexpr float QSCALE = 0.07216878364870322f * 1.4426950408889634f;
struct QKIn { u32x4 a0, a1; u32x2 r1, r2; };
__device__ __forceinline__ QKIn qk_load(const bf16* nope, const bf16* rope, int j) {
    QKIn q; q.a0 = *(const u32x4*)(nope + 16 * j); q.a1 = *(const u32x4*)(nope + 16 * j + 8); q.r1 = *(const u32x2*)(rope + 4 * j); q.r2 = *(const u32x2*)(rope + 32 + 4 * j); return q;
}
__device__ __forceinline__ void qk_finish(const QKIn& in, const float* g, bf16* dst, const float (&cs)[4], const float (&sn)[4], int j, float oscale) {
    const u32x4 a0 = in.a0, a1 = in.a1; const u32x2 r1 = in.r1, r2 = in.r2;
    float x[16], y1[4], y2[4];
#pragma unroll
    for (int k = 0; k < 4; ++k) { x[2 * k] = bf_lo(a0[k]); x[2 * k + 1] = bf_hi(a0[k]); x[8 + 2 * k] = bf_lo(a1[k]); x[8 + 2 * k + 1] = bf_hi(a1[k]); }
    y1[0] = bf_lo(r1.x); y1[1] = bf_hi(r1.x); y1[2] = bf_lo(r1.y); y1[3] = bf_hi(r1.y);
    y2[0] = bf_lo(r2.x); y2[1] = bf_hi(r2.x); y2[2] = bf_lo(r2.y); y2[3] = bf_hi(r2.y);
    float s = 0.f;
#pragma unroll
    for (int k = 0; k < 16; ++k) s += x[k] * x[k];
#pragma unroll
    for (int k = 0; k < 4; ++k) s += y1[k] * y1[k] + y2[k] * y2[k];
    s += __shfl_xor(s, 1); s += __shfl_xor(s, 2); s += __shfl_xor(s, 4);
    const float r = 1.0f / sqrtf(s * (1.0f / QKD) + EPS);
    const f32x4 g0 = *(const f32x4*)(g + 16 * j), g1 = *(const f32x4*)(g + 16 * j + 4), g2 = *(const f32x4*)(g + 16 * j + 8), g3 = *(const f32x4*)(g + 16 * j + 12);
    const f32x4 ga = *(const f32x4*)(g + 128 + 4 * j), gb = *(const f32x4*)(g + 160 + 4 * j);
    const float ro = r * oscale;
    u32x4 w0, w1;
    w0.x = cvt_pk_bf16(x[0] * ro * g0.x, x[1] * ro * g0.y); w0.y = cvt_pk_bf16(x[2] * ro * g0.z, x[3] * ro * g0.w); w0.z = cvt_pk_bf16(x[4] * ro * g1.x, x[5] * ro * g1.y); w0.w = cvt_pk_bf16(x[6] * ro * g1.z, x[7] * ro * g1.w);
    w1.x = cvt_pk_bf16(x[8] * ro * g2.x, x[9] * ro * g2.y); w1.y = cvt_pk_bf16(x[10] * ro * g2.z, x[11] * ro * g2.w); w1.z = cvt_pk_bf16(x[12] * ro * g3.x, x[13] * ro * g3.y); w1.w = cvt_pk_bf16(x[14] * ro * g3.z, x[15] * ro * g3.w);
    *(u32x4*)(dst + 16 * j) = w0; *(u32x4*)(dst + 16 * j + 8) = w1;
    float o1[4], o2[4];
#pragma unroll
    for (int k = 0; k < 4; ++k) { const float a = y1[k] * r * ga[k], b = y2[k] * r * gb[k]; o1[k] = (a * cs[k] - b * sn[k]) * oscale; o2[k] = (b * cs[k] + a * sn[k]) * oscale; }
    u32x2 v1, v2; v1.x = cvt_pk_bf16(o1[0], o1[1]); v1.y = cvt_pk_bf16(o1[2], o1[3]); v2.x = cvt_pk_bf16(o2[0], o2[1]); v2.y = cvt_pk_bf16(o2[2], o2[3]);
    *(u32x2*)(dst + 128 + 4 * j) = v1; *(u32x2*)(dst + 160 + 4 * j) = v2;
}
__device__ __forceinline__ void rope_cs(int pos, int j, float (&cs)[4], float (&sn)[4]) {
#pragma unroll
    for (int k = 0; k < 4; ++k) { const double rev = (double)pos * ROPE_REV[4 * j + k]; const float fr = (float)(rev - __builtin_floor(rev)); cs[k] = __builtin_amdgcn_cosf(fr); sn[k] = __builtin_amdgcn_sinf(fr); }
}
__device__ __forceinline__ void qk_token2(int t0, int t1, const int* positions, const bf16* Qraw, const bf16* Kraw, const bf16* Z, const float* qg, const float* kg, bf16* Q, bf16* K, int lane) {
    const int h = lane >> 3, j = lane & 7; const int p0 = positions[t0], p1 = positions[t1];
    const QKIn q0 = qk_load(Qraw + (size_t)t0 * QW + h * QKD, Qraw + (size_t)t0 * QW + h * QKD + 128, j), k0 = qk_load(Kraw + (size_t)t0 * 1024 + h * 128, Z + (size_t)t0 * ZLD + 3072, j);
    const QKIn q1 = qk_load(Qraw + (size_t)t1 * QW + h * QKD, Qraw + (size_t)t1 * QW + h * QKD + 128, j), k1 = qk_load(Kraw + (size_t)t1 * 1024 + h * 128, Z + (size_t)t1 * ZLD + 3072, j);
    float cs[4], sn[4];
    rope_cs(p0, j, cs, sn);
    qk_finish(q0, qg, Q + (size_t)t0 * QW + h * QKD, cs, sn, j, QSCALE); qk_finish(k0, kg, K + (size_t)t0 * QW + h * QKD, cs, sn, j, 1.0f);
    rope_cs(p1, j, cs, sn);
    qk_finish(q1, qg, Q + (size_t)t1 * QW + h * QKD, cs, sn, j, QSCALE); qk_finish(k1, kg, K + (size_t)t1 * QW + h * QKD, cs, sn, j, 1.0f);
}

namespace att {
constexpr int KP = 400, VP = 144, KBYTES = 64 * KP, VBYTES = 128 * VP, STAGE = KBYTES + VBYTES;
#define MFMA32(a, b, c) __builtin_amdgcn_mfma_f32_32x32x16_bf16((a), (b), (c), 0, 0, 0)
__device__ __forceinline__ void attn_unit(LAS unsigned char* lds, const bf16* Q, const bf16* K, const bf16* Vt, bf16* Y, const float* gout, int b, int h, int qb, const int tid) {
    const int lane = tid & 63, r32 = lane & 31, hi = lane >> 5; const int wid = __builtin_amdgcn_readfirstlane(tid >> 6);
    const int q0 = qb * 256, qrow = q0 + wid * 32 + r32;
    const size_t tok0 = (size_t)b * SEQ;
    bf16x8 qf[12];
    { const bf16* qp = Q + (tok0 + qrow) * QW + h * QKD + hi * 8;
#pragma unroll
      for (int dk = 0; dk < 12; ++dk) qf[dk] = *(const bf16x8*)(qp + dk * 16); }
    const bf16* ksrc = K + (tok0 + (tid >> 3)) * QW + h * QKD + (tid & 7) * 8;
    const unsigned kdst = (tid >> 3) * KP + (tid & 7) * 16;
    const bf16* vsrc = Vt + (size_t)(h * VD + (tid >> 2)) * VT_LD + tok0 + (tid & 3) * 8;
    const unsigned vdst = KBYTES + (tid >> 2) * VP + (tid & 3) * 16;
    const int NT = 4 * (qb + 1), my_last = 4 * qb + (wid >> 1);
    u32x4 kr[3], vr[2];
#pragma unroll
    for (int i = 0; i < 3; ++i) kr[i] = *(const u32x4*)(ksrc + i * 64);
#pragma unroll
    for (int i = 0; i < 2; ++i) vr[i] = *(const u32x4*)(vsrc + i * 32);
    __syncthreads();
#pragma unroll
    for (int i = 0; i < 3; ++i) *(LAS u32x4*)(lds + kdst + i * 128) = kr[i];
#pragma unroll
    for (int i = 0; i < 2; ++i) *(LAS u32x4*)(lds + vdst + i * 64) = vr[i];
    __syncthreads();
    const int pim = (r32 & 16) + ((r32 >> 2) & 1) * 8 + ((r32 >> 3) & 1) * 4 + (r32 & 3);
    const unsigned koff = pim * KP + hi * 16, voff = KBYTES + r32 * VP + hi * 16;
    f32x16 o[4];
#pragma unroll
    for (int d = 0; d < 4; ++d)
#pragma unroll
        for (int r = 0; r < 16; ++r) o[d][r] = 0.f;
    float m_run = -1e30f, l_run = 0.f;
    for (int t = 0; t < NT; ++t) {
        const unsigned bo = (t & 1) * STAGE;
        const bool more = (t + 1 < NT);
        if (more) {
#pragma unroll
            for (int i = 0; i < 3; ++i) kr[i] = *(const u32x4*)(ksrc + (size_t)(t + 1) * 64 * QW + i * 64);
#pragma unroll
            for (int i = 0; i < 2; ++i) vr[i] = *(const u32x4*)(vsrc + (t + 1) * 64 + i * 32);
        }
        if (t <= my_last) {
            f32x16 s0, s1;
#pragma unroll
            for (int r = 0; r < 16; ++r) { s0[r] = 0.f; s1[r] = 0.f; }
#pragma unroll
            for (int dk = 0; dk < 12; ++dk) {
                const bf16x8 k0 = *(const LAS bf16x8*)(lds + bo + koff + dk * 32), k1 = *(const LAS bf16x8*)(lds + bo + koff + 32 * KP + dk * 32);
                s0 = MFMA32(k0, qf[dk], s0); s1 = MFMA32(k1, qf[dk], s1);
            }
            if (t >= 4 * qb) {
                const int kb0 = 64 * t + 8 * hi;
#pragma unroll
                for (int r = 0; r < 16; ++r) { const int key = kb0 + 16 * (r >> 3) + (r & 7); if (key > qrow) s0[r] = -1e30f; if (key + 32 > qrow) s1[r] = -1e30f; }
            }
            float mx = s0[0];
#pragma unroll
            for (int r = 1; r < 16; ++r) mx = fmaxf(mx, s0[r]);
#pragma unroll
            for (int r = 0; r < 16; ++r) mx = fmaxf(mx, s1[r]);
            mx = fmaxf(mx, __shfl_xor(mx, 32));
            const float m_new = fmaxf(m_run, mx), alpha = __builtin_amdgcn_exp2f(m_run - m_new);
            m_run = m_new;
            float ls = 0.f;
#pragma unroll
            for (int r = 0; r < 16; ++r) { s0[r] = __builtin_amdgcn_exp2f(s0[r] - m_new); s1[r] = __builtin_amdgcn_exp2f(s1[r] - m_new); ls += s0[r] + s1[r]; }
            l_run = l_run * alpha + ls;
#pragma unroll
            for (int d = 0; d < 4; ++d)
#pragma unroll
                for (int r = 0; r < 16; ++r) o[d][r] *= alpha;
            u32x4 pw[4];
#pragma unroll
            for (int c = 0; c < 2; ++c) {
                pw[c] = (u32x4){cvt_pk_bf16(s0[8 * c], s0[8 * c + 1]), cvt_pk_bf16(s0[8 * c + 2], s0[8 * c + 3]), cvt_pk_bf16(s0[8 * c + 4], s0[8 * c + 5]), cvt_pk_bf16(s0[8 * c + 6], s0[8 * c + 7])};
                pw[2 + c] = (u32x4){cvt_pk_bf16(s1[8 * c], s1[8 * c + 1]), cvt_pk_bf16(s1[8 * c + 2], s1[8 * c + 3]), cvt_pk_bf16(s1[8 * c + 4], s1[8 * c + 5]), cvt_pk_bf16(s1[8 * c + 6], s1[8 * c + 7])};
            }
#pragma unroll
            for (int kc = 0; kc < 4; ++kc) {
                const bf16x8 pf = __builtin_bit_cast(bf16x8, pw[kc]);
#pragma unroll
                for (int d = 0; d < 4; ++d) { const bf16x8 vf = *(const LAS bf16x8*)(lds + bo + voff + d * 32 * VP + kc * 32); o[d] = MFMA32(vf, pf, o[d]); }
            }
        }
        if (more) {
            const unsigned nb = ((t + 1) & 1) * STAGE;
#pragma unroll
            for (int i = 0; i < 3; ++i) *(LAS u32x4*)(lds + nb + kdst + i * 128) = kr[i];
#pragma unroll
            for (int i = 0; i < 2; ++i) *(LAS u32x4*)(lds + nb + vdst + i * 64) = vr[i];
        }
        __syncthreads();
    }
    const float l = l_run + __shfl_xor(l_run, 32), inv = 1.0f / l;
    float ss = 0.f;
#pragma unroll
    for (int d = 0; d < 4; ++d)
#pragma unroll
        for (int r = 0; r < 16; ++r) { o[d][r] *= inv; ss += o[d][r] * o[d][r]; }
    ss += __shfl_xor(ss, 32);
    const float rn = 1.0f / sqrtf(ss * (1.0f / VD) + EPS);
    bf16* yp = Y + (tok0 + qrow) * DM + 1024 + h * VD + 4 * hi; const float* gp = gout + h * VD + 4 * hi;
#pragma unroll
    for (int d = 0; d < 4; ++d)
#pragma unroll
        for (int r4 = 0; r4 < 4; ++r4) { const f32x4 g = *(const f32x4*)(gp + 32 * d + 8 * r4); u32x2 w;
            w.x = cvt_pk_bf16(o[d][4 * r4] * rn * g.x, o[d][4 * r4 + 1] * rn * g.y); w.y = cvt_pk_bf16(o[d][4 * r4 + 2] * rn * g.z, o[d][4 * r4 + 3] * rn * g.w);
            *(u32x2*)(yp + 32 * d + 8 * r4) = w; }
}
}

namespace gm {
constexpr int WP = 272;
constexpr int WBYTES = 128 * WP;
__device__ __forceinline__ void gmlp_phase(LAS unsigned char* lds, const bf16* Z, const float* w_s, const float* b_s, const float* gout, const float* ssv, const float* gv, bf16* Y, int vcu, int G, const int tid) {
    const int lane = tid & 63, l16 = lane & 15, q4 = lane >> 4; const int wid = __builtin_amdgcn_readfirstlane(tid >> 6);
    int gcur = -1;
    u32x4 vreg[4]; float rvreg[4];
    if (vcu < 2048) { const int g = vcu & 7; const size_t tok0 = (size_t)(vcu >> 3) * 128;
#pragma unroll
        for (int i = 0; i < 4; ++i) { const int p = tid + 512 * i, s = p >> 4, seg = p & 15; vreg[i] = *(const u32x4*)(Z + (tok0 + s) * ZLD + 1024 + g * 128 + seg * 8); rvreg[i] = ssv[tok0 + s]; } }
    for (int un = vcu; un < 2048; un += G) {
        const int g = un & 7, bc = un >> 3;
        const size_t tok0 = (size_t)bc * 128;
        __syncthreads();
        if (g != gcur) {
            gcur = g;
#pragma unroll
            for (int i = 0; i < 8; ++i) { const int p = tid + 512 * i, t = p >> 5, s = (p & 31) * 4; const f32x4 w = *(const f32x4*)(w_s + (size_t)g * 16384 + t * 128 + s);
                u32x2 o; o.x = cvt_pk_bf16(s <= t ? w.x : 0.f, s + 1 <= t ? w.y : 0.f); o.y = cvt_pk_bf16(s + 2 <= t ? w.z : 0.f, s + 3 <= t ? w.w : 0.f);
                *(LAS u32x2*)(lds + t * WP + s * 2) = o; }
        }
#pragma unroll
        for (int i = 0; i < 4; ++i) { const int p = tid + 512 * i, s = p >> 4, seg = p & 15; const u32x4 v = vreg[i];
            const float rv = __builtin_amdgcn_rsqf(rvreg[i] * (1.0f / 1024.0f) + EPS); const f32x4 g0 = *(const f32x4*)(gv + g * 128 + seg * 8), g1 = *(const f32x4*)(gv + g * 128 + seg * 8 + 4);
            LAS unsigned short* dst = (LAS unsigned short*)(lds + WBYTES + (seg * 8) * WP + s * 2);
            const unsigned w0 = cvt_pk_bf16(bf_lo(v.x) * rv * g0.x, bf_hi(v.x) * rv * g0.y), w1 = cvt_pk_bf16(bf_lo(v.y) * rv * g0.z, bf_hi(v.y) * rv * g0.w);
            const unsigned w2 = cvt_pk_bf16(bf_lo(v.z) * rv * g1.x, bf_hi(v.z) * rv * g1.y), w3 = cvt_pk_bf16(bf_lo(v.w) * rv * g1.z, bf_hi(v.w) * rv * g1.w);
            dst[0 * (WP / 2)] = (unsigned short)(w0 & 0xffffu); dst[1 * (WP / 2)] = (unsigned short)(w0 >> 16); dst[2 * (WP / 2)] = (unsigned short)(w1 & 0xffffu); dst[3 * (WP / 2)] = (unsigned short)(w1 >> 16);
            dst[4 * (WP / 2)] = (unsigned short)(w2 & 0xffffu); dst[5 * (WP / 2)] = (unsigned short)(w2 >> 16); dst[6 * (WP / 2)] = (unsigned short)(w3 & 0xffffu); dst[7 * (WP / 2)] = (unsigned short)(w3 >> 16); }
        if (un + G < 2048) { const int gn = (un + G) & 7; const size_t tokn = (size_t)((un + G) >> 3) * 128;
#pragma unroll
            for (int i = 0; i < 4; ++i) { const int p = tid + 512 * i, s = p >> 4, seg = p & 15; vreg[i] = *(const u32x4*)(Z + (tokn + s) * ZLD + 1024 + gn * 128 + seg * 8); rvreg[i] = ssv[tokn + s]; } }
        const int tt = 16 * wid + l16; const float bs = b_s[g * 128 + tt];
        const bf16* up = Z + (tok0 + tt) * ZLD + g * 128 + 4 * q4;
        u32x2 ureg[8];
#pragma unroll
        for (int d = 0; d < 8; ++d) ureg[d] = *(const u32x2*)(up + 16 * d);
        __syncthreads();
        pg8::f32x4 acc[8];
#pragma unroll
        for (int d = 0; d < 8; ++d) acc[d] = (pg8::f32x4){0.f, 0.f, 0.f, 0.f};
        const int nsb = (wid >> 1) + 1;
        for (int sb = 0; sb < nsb; ++sb) {
            const bf16x8 wf = *(const LAS bf16x8*)(lds + (16 * wid + l16) * WP + sb * 64 + q4 * 16);
#pragma unroll
            for (int d = 0; d < 8; ++d) { const bf16x8 vf = *(const LAS bf16x8*)(lds + WBYTES + (16 * d + l16) * WP + sb * 64 + q4 * 16); acc[d] = __builtin_amdgcn_mfma_f32_16x16x32_bf16(vf, wf, acc[d], 0, 0, 0); }
        }
        const int t = tt;
        float ss = 0.f;
#pragma unroll
        for (int d = 0; d < 8; ++d) { const u32x2 uu = ureg[d];
            acc[d][0] = bf_lo(uu.x) * (acc[d][0] + bs); acc[d][1] = bf_hi(uu.x) * (acc[d][1] + bs); acc[d][2] = bf_lo(uu.y) * (acc[d][2] + bs); acc[d][3] = bf_hi(uu.y) * (acc[d][3] + bs);
            ss += (acc[d][0] * acc[d][0] + acc[d][1] * acc[d][1]) + (acc[d][2] * acc[d][2] + acc[d][3] * acc[d][3]); }
        ss += __shfl_xor(ss, 16); ss += __shfl_xor(ss, 32);
        const float rn = 1.0f / sqrtf(ss * (1.0f / 128.0f) + EPS);
        bf16* yp = Y + (tok0 + t) * DM + g * 128 + 4 * q4; const float* gp = gout + g * 128 + 4 * q4;
#pragma unroll
        for (int d = 0; d < 8; ++d) { const f32x4 gg = *(const f32x4*)(gp + 16 * d); u32x2 w; w.x = cvt_pk_bf16(acc[d][0] * rn * gg.x, acc[d][1] * rn * gg.y); w.y = cvt_pk_bf16(acc[d][2] * rn * gg.z, acc[d][3] * rn * gg.w);
            *(u32x2*)(yp + 16 * d) = w; }
    }
}
}

#define XB_TMO      128
#define XB_XCNT(j)  (256  + 64 * (j))
#define XB_XSUB(j)  (1280 + 64 * (j))
#define XB_XGEN(j)  (2304 + 64 * (j))
#define XB_TOP      3328
#define XB_TOPGEN   3392
#define XCD_BAR_WORDS 3456
#define XB_SPIN_CAP (1u << 18)

__device__ __forceinline__ unsigned xb_ld(unsigned* p)              { return __hip_atomic_load(p, __ATOMIC_RELAXED, __HIP_MEMORY_SCOPE_AGENT); }
__device__ __forceinline__ unsigned xb_add(unsigned* p, unsigned v) { return __hip_atomic_fetch_add(p, v, __ATOMIC_RELAXED, __HIP_MEMORY_SCOPE_AGENT); }
__device__ __forceinline__ unsigned xb_xcc_id() { return (unsigned)__builtin_amdgcn_s_getreg((3 << 11) | 20) & 0xFu; }
#define XB_SPIN(cond, bar) do { unsigned _sp = 0; while (cond) { __builtin_amdgcn_s_sleep(1); \
    if ((++_sp & 255u) == 0u) { if (xb_ld(&(bar)[XB_TMO])) break; if (_sp > XB_SPIN_CAP) { atomicAdd(&(bar)[XB_TMO], 1u); break; } } } } while (0)

struct XcdBarrier {
    unsigned* bar; unsigned x;
    volatile LAS unsigned* st;
};

__device__ __forceinline__ XcdBarrier xcd_barrier_post(unsigned* bar, volatile LAS unsigned* st) {
    XcdBarrier b; b.bar = bar; b.x = xb_xcc_id(); b.st = st;
    if (threadIdx.x == 0) (void)xb_add(&bar[XB_XCNT(b.x)], 1u);
    return b;
}
__device__ __forceinline__ void xcd_barrier_complete(unsigned* bar, unsigned x, unsigned& nloc, unsigned& nx) {
    const unsigned G = gridDim.x * gridDim.y * gridDim.z;
    unsigned sum, cnt, mine, sp = 0u;
    for (;;) {
        sum = 0u; cnt = 0u; mine = 0u;
#pragma unroll
        for (unsigned j = 0; j < 16; ++j) { const unsigned c = xb_ld(&bar[XB_XCNT(j)]); sum += c; cnt += (c > 0u) ? 1u : 0u; mine = (j == x) ? c : mine; }
        if (sum == G) break;
        __builtin_amdgcn_s_sleep(1);
        if ((++sp & 255u) == 0u) { if (xb_ld(&bar[XB_TMO])) break; if (sp > XB_SPIN_CAP) { atomicAdd(&bar[XB_TMO], 1u); break; } }
    }
    nloc = mine > 0u ? mine : 1u; nx = cnt > 0u ? cnt : 1u;
}

__device__ __forceinline__ void xcd_barrier(const XcdBarrier& b) {
    asm volatile("s_waitcnt vmcnt(0)" ::: "memory");
    __syncthreads();
    if (threadIdx.x == 0) {
        unsigned* bar = b.bar;
        __builtin_amdgcn_s_waitcnt(0);
        unsigned nloc = b.st[0], nx = b.st[1];
        if (nloc == 0u) { xcd_barrier_complete(bar, b.x, nloc, nx); b.st[0] = nloc; b.st[1] = nx; }
        const unsigned old = xb_add(&bar[XB_XSUB(b.x)], 1u);
        const unsigned gen = old / nloc;
        if (old + 1u == (gen + 1u) * nloc) {
            __builtin_amdgcn_fence(__ATOMIC_RELEASE, "agent");
            asm volatile("s_waitcnt vmcnt(0)" ::: "memory");
            const unsigned og = xb_add(&bar[XB_TOP], 1u);
            const unsigned tg = og / nx;
            if (og + 1u == (tg + 1u) * nx) xb_add(&bar[XB_TOPGEN], 1u);
            else XB_SPIN(xb_ld(&bar[XB_TOPGEN]) == tg, bar);
            __builtin_amdgcn_fence(__ATOMIC_ACQUIRE, "agent");
            xb_add(&bar[XB_XGEN(b.x)], 1u);
            asm volatile("s_waitcnt vmcnt(0)" ::: "memory");
        } else {
            XB_SPIN(xb_ld(&bar[XB_XGEN(b.x)]) == gen, bar);
            __builtin_amdgcn_fence(__ATOMIC_ACQUIRE, "agent");
            asm volatile("s_waitcnt vmcnt(0)" ::: "memory");
        }
    }
    __syncthreads();
}

constexpr int LDS_BYTES = 147456;
constexpr int NPHASE = 10;
#ifndef DUP_MASK
#define DUP_MASK 0
#endif
struct Args { const float* in[24]; float* out; unsigned char* ws; int ph_lo, ph_hi; };
static_assert(offsetof(Args, out) == 192 && offsetof(Args, ws) == 200, "kernarg offsets");

__global__ void __launch_bounds__(512, 2) fwd_megakernel(Args a) {
    extern __shared__ __attribute__((aligned(16))) unsigned char lds_raw[];
    LAS unsigned char* lds = (LAS unsigned char*)lds_raw;
    cg::grid_group grid = cg::this_grid();
    volatile LAS unsigned* MISC = (volatile LAS unsigned*)(lds + 131072 + 512);
    if (threadIdx.x < 4) MISC[threadIdx.x] = 0u;
    __syncthreads();
    const XcdBarrier bar = xcd_barrier_post((unsigned*)(a.ws + WS_BAR), MISC);
    const int G = gridDim.x, bx = blockIdx.x; const int vcu = (G % 8 == 0) ? (bx % 8) * (G / 8) + bx / 8 : bx;
    const int NGW = G * 8;
    for (int ph = a.ph_lo; ph < a.ph_hi; ++ph) {
    int rep = 0;
phase_again:
    int tid = threadIdx.x; asm volatile("" : "+v"(tid));
    const __attribute__((address_space(4))) char* kp = (const __attribute__((address_space(4))) char*)__builtin_amdgcn_kernarg_segment_ptr(); asm volatile("" : "+s"(kp));
#define KIN(i) (*(const float* const __attribute__((address_space(4)))*)(kp + 8 * (i)))
    unsigned char* ws = *(unsigned char* const __attribute__((address_space(4)))*)(kp + 200); float* out = *(float* const __attribute__((address_space(4)))*)(kp + 192);
    const int lane = tid & 63, wave = __builtin_amdgcn_readfirstlane(tid >> 6), gw = vcu * 8 + wave;
    bf16* XN = (bf16*)(ws + WS_XN); bf16* Yb = (bf16*)(ws + WS_Y); bf16* H = (bf16*)(ws + WS_H); bf16* Z = (bf16*)(ws + WS_Z);
    bf16* QRAW = (bf16*)(ws + WS_QRAW); bf16* KRAW = (bf16*)(ws + WS_KRAW); bf16* VT = (bf16*)(ws + WS_VT); bf16* Qb = (bf16*)(ws + WS_Q); bf16* Kb = (bf16*)(ws + WS_K);
        const bool is_gemm = (ph == 1 || ph == 2 || ph == 3 || ph == 4 || ph == 7 || ph == 8 || ph == 9);
        float* SS = (float*)(ws + WS_SS); bf16* XB1 = (bf16*)out;
        if (is_gemm) {
            const int nsub = (ph == 4) ? 3 : 1;
            for (int sub = 0; sub < nsub; ++sub) {
                pg8::Gemm g; pg8::Epi E; E.mode = 0; E.O = nullptr; E.ldc = 0; E.base = nullptr; E.base_bf = nullptr; E.out = nullptr; E.alpha = 0.f; E.rs = nullptr; E.rs_invn = 1.0f / DM; E.xb = nullptr; E.ss_out = nullptr;
                if (ph == 1) { g = pg8::Gemm{XN, (const bf16*)(ws + WS_WGU1), MTOK, NGU, DM, DM, DM}; E.mode = 2; E.O = H; E.ldc = DFF; }
                else if (ph == 8) { g = pg8::Gemm{(const bf16*)(ws + WS_XB2), (const bf16*)(ws + WS_WGU2), MTOK, NGU, DM, DM, DM}; E.mode = 2; E.O = H; E.ldc = DFF; E.rs = SS + MTOK; }
                else if (ph == 2) { g = pg8::Gemm{H, (const bf16*)(ws + WS_WD1), MTOK, DM, DFF, DFF, DFF}; E.mode = 3; E.base = KIN(0); E.ldc = DM; E.alpha = 0.5f; E.xb = XB1; E.ss_out = SS; }
                else if (ph == 9) { g = pg8::Gemm{H, (const bf16*)(ws + WS_WD2), MTOK, DM, DFF, DFF, DFF}; E.mode = 3; E.base_bf = (const bf16*)(ws + WS_XB2); E.out = out; E.ldc = DM; E.alpha = 0.5f; }
                else if (ph == 3) { g = pg8::Gemm{XB1, (const bf16*)(ws + WS_WIN), MTOK, ZLD, DM, DM, DM}; E.mode = 1; E.O = Z; E.ldc = ZLD; E.rs = SS; E.ss_out = SS + 2 * MTOK; }
                else if (ph == 7) { g = pg8::Gemm{Yb, (const bf16*)(ws + WS_WOUT), MTOK, DM, DM, DM, DM}; E.mode = 3; E.base_bf = XB1; E.ldc = DM; E.alpha = 1.0f; E.xb = (bf16*)(ws + WS_XB2); E.ss_out = SS + MTOK; }
                else if (sub == 0) { g = pg8::Gemm{Z + 2048, (const bf16*)(ws + WS_WQ), MTOK, QW, 512, ZLD, 512}; E.O = QRAW; E.ldc = QW; E.rs = SS + 3 * MTOK; E.rs_invn = 1.0f / 512.0f; }
                else if (sub == 1) { g = pg8::Gemm{Z + 2560, (const bf16*)(ws + WS_WK), MTOK, 1024, 512, ZLD, 512}; E.O = KRAW; E.ldc = 1024; E.rs = SS + 4 * MTOK; E.rs_invn = 1.0f / 512.0f; }
                else { g = pg8::Gemm{(const bf16*)(ws + WS_WV), Z + 2560, 1024, MTOK, 512, 512, ZLD}; E.mode = 4; E.O = VT; E.ldc = VT_LD; E.rs = SS + 4 * MTOK; E.rs_invn = 1.0f / 512.0f; }
                pg8::StaticOrder S; S.init(g.M, g.N, G, bx, (ph == 2 || ph == 7 || ph == 9) ? 4 : 8);
#ifndef NO_GEMM
                pg8::gemm_phase(lds, g, S, E, tid);
#endif
            }
#ifndef NO_GM
            if (ph == 4) gm::gmlp_phase(lds, Z, KIN(9), KIN(10), KIN(17), SS + 2 * MTOK, KIN(8), Yb, vcu, G, tid);
#endif
        } else if (ph == 0) {
            p0_weights(lds, ws, KIN(3), KIN(4), KIN(5), KIN(21), KIN(22), KIN(23), KIN(7), KIN(12), KIN(14), KIN(19), KIN(6), KIN(20), KIN(11), KIN(13), gw, NGW, wave, lane);
            for (int m = gw; m < MTOK; m += NGW) rms_row_to_bf16(KIN(0) + (size_t)m * DM, KIN(2), XN + (size_t)m * DM, lane);
        } else if (ph == 5) {
            for (int m = gw; m < MTOK; m += 2 * NGW) qk_token2(m, (m + NGW < MTOK) ? m + NGW : m, (const int*)KIN(1), QRAW, KRAW, Z, KIN(15), KIN(16), Qb, Kb, lane);
        } else if (ph == 6) {
            for (int v = vcu; v < 256; v += G) { const int bh = v >> 1, s0 = (v & 1) * 2;
#pragma unroll 1
                for (int i = 0; i < 4; ++i) { const int qb = (i == 0) ? 7 - s0 : (i == 1) ? s0 : (i == 2) ? 6 - s0 : s0 + 1;
#ifndef NO_ATT
                    att::attn_unit(lds, Qb, Kb, VT, Yb, KIN(18), bh >> 3, bh & 7, qb, tid);
#endif
                } }
        }
        if (ph + 1 < a.ph_hi) { if (ph == 0) grid.sync(); else xcd_barrier(bar); }
#if DUP_MASK
        if (((DUP_MASK >> ph) & 1) && rep == 0) { rep = 1; if (ph + 1 >= a.ph_hi) grid.sync(); goto phase_again; }
#endif
    }
}

extern "C" void kernel_launch(void* const* d_in, const int* in_sizes, int n_in, void* d_out, int out_size, void* d_ws, size_t ws_size, hipStream_t stream) {
    static int grid = 0;
    if (grid == 0) {
        if (n_in != 24 || out_size != MTOK * DM || ws_size < WS_END) { fprintf(stderr, "kernel_launch: unexpected problem (n_in %d, out %d, ws %zu); nothing launched\n", n_in, out_size, ws_size); grid = -1; return; }
        int dev = 0, cus = 0, per_cu = 0;
        if (hipGetDevice(&dev) != hipSuccess || hipDeviceGetAttribute(&cus, hipDeviceAttributeMultiprocessorCount, dev) != hipSuccess) { grid = -1; return; }
        if (hipFuncSetAttribute((const void*)fwd_megakernel, hipFuncAttributeMaxDynamicSharedMemorySize, LDS_BYTES) != hipSuccess) { fprintf(stderr, "kernel_launch: hipFuncSetAttribute failed\n"); grid = -1; return; }
        if (hipOccupancyMaxActiveBlocksPerMultiprocessor(&per_cu, (const void*)fwd_megakernel, 512, LDS_BYTES) != hipSuccess || per_cu < 1) { fprintf(stderr, "kernel_launch: occupancy query says %d\n", per_cu); per_cu = 1; }
        (void)hipGetLastError();
        grid = cus * per_cu;
        if (grid % 8 != 0 || grid > 2048) grid = cus;
    }
    if (grid < 0) return;
    if (hipMemsetAsync((char*)d_ws + WS_BAR, 0, XCD_BAR_WORDS * 4, stream) != hipSuccess) { fprintf(stderr, "kernel_launch: memset of the barrier words failed\n"); return; }
    Args a{};
    for (int i = 0; i < 24; ++i) a.in[i] = (const float*)d_in[i];
    a.out = (float*)d_out; a.ws = (unsigned char*)d_ws;
#if MK_MULTI
    for (int ph = 0; ph < NPHASE; ++ph) { a.ph_lo = ph; a.ph_hi = ph + 1; hipLaunchKernelGGL(fwd_megakernel, dim3(grid), dim3(512), LDS_BYTES, stream, a); }
#else
    a.ph_lo = 0; a.ph_hi = NPHASE;
    void* args[] = {&a};
    hipError_t e = hipLaunchCooperativeKernel((const void*)fwd_megakernel, dim3(grid), dim3(512), args, LDS_BYTES, stream);
    if (e != hipSuccess) fprintf(stderr, "kernel_launch: cooperative launch failed: %s (grid %d)\n", hipGetErrorString(e), grid);
#endif
}
```

```cpp
#include <hip/hip_runtime.h>
#include <hip/hip_cooperative_groups.h>
#include <cstdio>
#include <cstdint>
#include <cstddef>
namespace cg = cooperative_groups;

#ifndef MK_MULTI
#define MK_MULTI 0
#endif

constexpr int BATCH = 16, SEQ = 2048, DM = 2048, MTOK = BATCH * SEQ, DFF = 5504, NGU = 2 * DFF;
constexpr int ZLD = 3328;
constexpr int NH = 8, QKD = 192, VD = 128, QW = NH * QKD  ;
constexpr float EPS = 1e-6f;

namespace pg8 {
#define PG8_LAS __attribute__((address_space(3)))
typedef unsigned short bf16_t;
typedef short bf16x8 __attribute__((ext_vector_type(8)));
typedef float f32x4 __attribute__((ext_vector_type(4)));
typedef float f32x2 __attribute__((ext_vector_type(2)));
typedef unsigned u32x4 __attribute__((ext_vector_type(4)));
typedef unsigned u32x2 __attribute__((ext_vector_type(2)));
typedef __bf16 bf16x2_t __attribute__((ext_vector_type(2)));
constexpr int BM = 256, BK = 64, HALF = 128, HTB = HALF * BK * 2  , STAGE_BYTES = 8 * HTB, NXCD = 8, WGM = 8;

__host__ __device__ __forceinline__ int lds_byte(int r, int c) { const int st = (r >> 4) * 2 + (c >> 5), rr = r & 15, cc = c & 31, ob = rr * 64 + cc * 2; return st * 1024 + (ob ^ (((ob >> 9) & 1) << 5)); }
__host__ __device__ __forceinline__ void stage_rc(int b, int& R, int& C) { const int st = b / 1024, sb = b % 1024, swz = sb ^ (((sb >> 9) & 1) << 5); R = (st >> 1) * 16 + swz / 64; C = (st & 1) * 32 + (swz % 64) / 2; }
__host__ __device__ __forceinline__ int perm32(int rho) { const int n = rho >> 4, i = rho & 15; return 8 * (i >> 2) + 4 * n + (i & 3); }

struct Unit { int pm, pn; };
struct Gemm { const bf16_t* A; const bf16_t* Bt; int M, N, K, lda, ldb; };

struct StaticOrder {
    int nM, nN, nwg, G, c, wgm;
    __host__ __device__ void init(int M, int N, int G_, int c_, int wgm_) { nM = M / BM; nN = N / BM; nwg = nM * nN; G = G_; c = c_; wgm = wgm_; }
    __host__ __device__ bool next(int i, Unit& u) const {
        const long L = (long)i * G + c; if (L >= nwg) return false;
        int wgid = (int)L; { const int q = nwg / NXCD, r = nwg % NXCD, xcd = wgid % NXCD, off = wgid / NXCD; wgid = (xcd < r ? xcd * (q + 1) : r * (q + 1) + (xcd - r) * q) + off; }
        const int nig = wgm * nN, gid = wgid / nig, fm = gid * wgm, gsz = (nM - fm) < wgm ? (nM - fm) : wgm;
        u.pm = fm + ((wgid % nig) % gsz); u.pn = (wgid % nig) / gsz; return true;
    }
};

__device__ __forceinline__ unsigned cvt_pk_bf16(float lo, float hi) { f32x2 v = {lo, hi}; bf16x2_t b = __builtin_convertvector(v, bf16x2_t); return __builtin_bit_cast(unsigned, b); }
__device__ __forceinline__ f32x2 gelu_pk(f32x2 v) {
    const f32x2 av = __builtin_elementwise_abs(v), d = av * 0.2316418882f + 1.0f;
    f32x2 t; t.x = __builtin_amdgcn_rcpf(d.x); t.y = __builtin_amdgcn_rcpf(d.y);
    f32x2 q = t * 0.5307027145f + (-0.7265760135f); q = q * t + 0.7107068705f; q = q * t + (-0.142248368f); q = q * t + 0.127414796f; q = q * t;
    const f32x2 s = (v * v) * (-0.72134752044f);
    f32x2 e; e.x = __builtin_amdgcn_exp2f(s.x); e.y = __builtin_amdgcn_exp2f(s.y);
    const f32x2 m = v * (q * e), r = v - m;
    f32x2 o; o.x = v.x < 0.f ? m.x : r.x; o.y = v.y < 0.f ? m.y : r.y; return o;
}
__device__ __forceinline__ f32x4 gelu4(f32x4 v) { f32x2 a = gelu_pk((f32x2){v[0], v[1]}), b = gelu_pk((f32x2){v[2], v[3]}); return (f32x4){a.x, a.y, b.x, b.y}; }
__device__ __forceinline__ float silu_mul(float g, float u) { return g * u * __builtin_amdgcn_rcpf(1.0f + __builtin_amdgcn_exp2f(-1.4426950408889634f * g)); }

struct Epi {
    int mode; bf16_t* O; int ldc; const float* base; const bf16_t* base_bf; float* out; float alpha; const float* rs; float rs_invn; bf16_t* xb; float* ss_out;
    __device__ __forceinline__ void operator()(const f32x4 (&acc)[2][2][4][2], const Unit& u, int wr, int wc, int fr, int fq) const {
        const int row0 = u.pm * BM + wr * 64 + fr;
#ifdef FORCE_MODE
        const int mode = FORCE_MODE;
#endif
        if (mode == 3) {
            const int col0 = u.pn * BM + wc * 32 + 8 * fq;
#pragma unroll
            for (int ai = 0; ai < 2; ++ai)
#pragma unroll
                for (int m = 0; m < 4; ++m) { const int row = row0 + ai * HALF + m * 16; const size_t off = (size_t)row * ldc + col0; float ssr = 0.f;
#pragma unroll
                    for (int bj = 0; bj < 2; ++bj) { f32x4 b0, b1;
                        if (base_bf) { const u32x4 t = *(const u32x4*)(base_bf + off + bj * HALF);
                            b0 = (f32x4){__uint_as_float(t.x << 16), __uint_as_float(t.x & 0xffff0000u), __uint_as_float(t.y << 16), __uint_as_float(t.y & 0xffff0000u)};
                            b1 = (f32x4){__uint_as_float(t.z << 16), __uint_as_float(t.z & 0xffff0000u), __uint_as_float(t.w << 16), __uint_as_float(t.w & 0xffff0000u)}; }
                        else { b0 = *(const f32x4*)(base + off + bj * HALF); b1 = *(const f32x4*)(base + off + bj * HALF + 4); }
                        const f32x4 o0 = b0 + acc[ai][bj][m][0] * alpha, o1 = b1 + acc[ai][bj][m][1] * alpha;
                        if (out) { *(f32x4*)(out + off + bj * HALF) = o0; *(f32x4*)(out + off + bj * HALF + 4) = o1; }
                        if (xb) { ssr += (o0[0] * o0[0] + o0[1] * o0[1]) + (o0[2] * o0[2] + o0[3] * o0[3]) + (o1[0] * o1[0] + o1[1] * o1[1]) + (o1[2] * o1[2] + o1[3] * o1[3]);
                            u32x4 w; w.x = cvt_pk_bf16(o0[0], o0[1]); w.y = cvt_pk_bf16(o0[2], o0[3]); w.z = cvt_pk_bf16(o1[0], o1[1]); w.w = cvt_pk_bf16(o1[2], o1[3]); *(u32x4*)(xb + off + bj * HALF) = w; } }
                    if (xb) { ssr += __shfl_xor(ssr, 16); ssr += __shfl_xor(ssr, 32); if (fq == 0) atomicAdd(ss_out + row, ssr); }
                    if (m == 3) asm volatile("" ::: "memory"); }
            return;
        }
        f32x4 cs[2][2];
#pragma unroll
        for (int bj = 0; bj < 2; ++bj)
#pragma unroll
            for (int n = 0; n < 2; ++n) cs[bj][n] = (f32x4){1.f, 1.f, 1.f, 1.f};
        if (mode == 4) {
            const int c0 = u.pn * BM + wc * 32 + 8 * fq;
#pragma unroll
            for (int bj = 0; bj < 2; ++bj)
#pragma unroll
                for (int n = 0; n < 2; ++n) { const f32x4 s = *(const f32x4*)(rs + c0 + bj * HALF + 4 * n);
#pragma unroll
                    for (int i = 0; i < 4; ++i) cs[bj][n][i] = __builtin_amdgcn_rsqf(s[i] * rs_invn + 1e-6f); }
        }
        const bool rowscale = (rs != nullptr) && (mode != 4);
        const bool act = (mode == 1) && (u.pn < 8), stat = (mode == 1) && (u.pn >= 4) && (u.pn < 12);
        float* ssp = ss_out + (u.pn < 8 ? 0 : (u.pn < 10 ? 32768 : 65536));
        const int col0 = (mode == 2 ? u.pn * HALF : u.pn * BM) + wc * 32 + 8 * fq;
#pragma unroll
        for (int ai = 0; ai < 2; ++ai)
#pragma unroll
            for (int m = 0; m < 4; ++m) { const int row = row0 + ai * HALF + m * 16; bf16_t* rowp = O + (size_t)row * ldc + col0;
                float r = 1.0f; if (rowscale) r = __builtin_amdgcn_rsqf(rs[row] * rs_invn + 1e-6f);
                if (mode == 2) {
                    const f32x4 g0 = acc[ai][0][m][0] * r, g1 = acc[ai][0][m][1] * r, u0 = acc[ai][1][m][0] * r, u1 = acc[ai][1][m][1] * r;
                    u32x4 w; w.x = cvt_pk_bf16(silu_mul(g0[0], u0[0]), silu_mul(g0[1], u0[1])); w.y = cvt_pk_bf16(silu_mul(g0[2], u0[2]), silu_mul(g0[3], u0[3]));
                    w.z = cvt_pk_bf16(silu_mul(g1[0], u1[0]), silu_mul(g1[1], u1[1])); w.w = cvt_pk_bf16(silu_mul(g1[2], u1[2]), silu_mul(g1[3], u1[3]));
                    *(u32x4*)rowp = w;
                } else {
                    float ssr = 0.f;
#pragma unroll
                    for (int bj = 0; bj < 2; ++bj) { f32x4 v0 = acc[ai][bj][m][0] * cs[bj][0] * r, v1 = acc[ai][bj][m][1] * cs[bj][1] * r;
                        if (act) { v0 = gelu4(v0); v1 = gelu4(v1); }
                        ssr += (v0[0] * v0[0] + v0[1] * v0[1]) + (v0[2] * v0[2] + v0[3] * v0[3]) + (v1[0] * v1[0] + v1[1] * v1[1]) + (v1[2] * v1[2] + v1[3] * v1[3]);
                        u32x4 w; w.x = cvt_pk_bf16(v0[0], v0[1]); w.y = cvt_pk_bf16(v0[2], v0[3]); w.z = cvt_pk_bf16(v1[0], v1[1]); w.w = cvt_pk_bf16(v1[2], v1[3]);
                        *(u32x4*)(rowp + bj * HALF) = w; }
                    if (stat) { ssr += __shfl_xor(ssr, 16); ssr += __shfl_xor(ssr, 32); if (fq == 0) atomicAdd(ssp + row, ssr); }
                }
            }
    }
};

__device__ __forceinline__ void gemm_phase(PG8_LAS unsigned char* lds, const Gemm g, const StaticOrder& S, const Epi& E, const int tid) {
    const int wid = __builtin_amdgcn_readfirstlane(tid >> 6), lane = tid & 63, wr = wid >> 2, wc = wid & 3, fr = lane & 15, fq = lane >> 4;
    const int K = g.K, nt = K / BK;
    unsigned voffA[2], voffB[2];
#pragma unroll
    for (int i = 0; i < 2; ++i) { int R, C; stage_rc(tid * 16 + i * 8192, R, C); const int Rb = (R & ~31) + perm32(R & 31);
        voffA[i] = (unsigned)(R * g.lda + C) * 2u; voffB[i] = (unsigned)(Rb * g.ldb + C) * 2u; }
    const size_t kstep = (size_t)(BK * 2);
    const size_t hstepA = (size_t)HALF * g.lda * 2, hstepB = (size_t)HALF * g.ldb * 2;
    const size_t tstepA = 2 * hstepA, tstepB = 2 * hstepB;
    const unsigned ldsw = (unsigned)wid * 1024u;
    const int aoff = lds_byte(wr * 64 + fr, fq * 8), boff = lds_byte(wc * 32 + fr, fq * 8);
#define PG8_SA(b, h) (((b) * 2 + (h)) * HTB)
#define PG8_SB(b, h) ((4 + (b) * 2 + (h)) * HTB)
#define PG8_STAGE(bufoff, gbase, voff) do { _Pragma("unroll") for (int _i = 0; _i < 2; ++_i) \
        __builtin_amdgcn_global_load_lds((const unsigned*)((const char*)(gbase) + (voff)[_i]), (PG8_LAS unsigned*)(lds + (bufoff) + ldsw + _i * 8192), 16, 0, 0); } while (0)
#define PG8_LDA(dst, b, h) do { _Pragma("unroll") for (int m = 0; m < 4; ++m) _Pragma("unroll") for (int k = 0; k < 2; ++k) dst[m][k] = *(const PG8_LAS bf16x8*)(lds + PG8_SA(b, h) + aoff + m * 2048 + k * 1024); } while (0)
#define PG8_LDB(dst, b, h) do { _Pragma("unroll") for (int n = 0; n < 2; ++n) _Pragma("unroll") for (int k = 0; k < 2; ++k) dst[n][k] = *(const PG8_LAS bf16x8*)(lds + PG8_SB(b, h) + boff + n * 2048 + k * 1024); } while (0)
#define PG8_MMA(ai, bj, At, Bt) do { __builtin_amdgcn_s_setprio(1); _Pragma("unroll") for (int m = 0; m < 4; ++m) _Pragma("unroll") for (int n = 0; n < 2; ++n) _Pragma("unroll") for (int k = 0; k < 2; ++k) \
        acc[ai][bj][m][n] = __builtin_amdgcn_mfma_f32_16x16x32_bf16(Bt[n][k], At[m][k], acc[ai][bj][m][n], 0, 0, 0); __builtin_amdgcn_s_setprio(0); } while (0)
#define PG8_WAIT_V(n) asm volatile("s_waitcnt vmcnt(" #n ")" ::: "memory")
#define PG8_WAIT_L(n) asm volatile("s_waitcnt lgkmcnt(" #n ")" ::: "memory")
#define PG8_BAR __builtin_amdgcn_s_barrier()
#define PG8_SCHED __builtin_amdgcn_sched_barrier(0)
    Unit cur, nxt; int ui = 0;
    if (!S.next(0, cur)) return;
    f32x4 acc[2][2][4][2];
#pragma unroll
    for (int a = 0; a < 2; ++a)
#pragma unroll
        for (int b = 0; b < 2; ++b)
#pragma unroll
            for (int m = 0; m < 4; ++m)
#pragma unroll
                for (int n = 0; n < 2; ++n) acc[a][b][m][n] = (f32x4){0.f, 0.f, 0.f, 0.f};
    bf16x8 At[4][2], B0[2][2], B1[2][2];
    const char* cA = (const char*)g.A + (size_t)cur.pm * tstepA; const char* cB = (const char*)g.Bt + (size_t)cur.pn * tstepB;
    PG8_STAGE(PG8_SB(0, 0), cB, voffB); PG8_STAGE(PG8_SB(0, 1), cB + hstepB, voffB); PG8_STAGE(PG8_SA(0, 0), cA, voffA); PG8_STAGE(PG8_SA(0, 1), cA + hstepA, voffA);
    if (wr == 1) PG8_BAR;
    PG8_WAIT_V(2); PG8_BAR;
    PG8_STAGE(PG8_SB(1, 0), cB + kstep, voffB); PG8_STAGE(PG8_SA(1, 0), cA + kstep, voffA); PG8_STAGE(PG8_SB(1, 1), cB + hstepB + kstep, voffB);
    PG8_WAIT_V(6); PG8_BAR;
    for (;;) {
        const bool has_next = S.next(ui + 1, nxt);
        const char* nA = has_next ? (const char*)g.A + (size_t)nxt.pm * tstepA : cA; const char* nB = has_next ? (const char*)g.Bt + (size_t)nxt.pn * tstepB : cB;
        for (int t = 0; t < nt; t += 2) {
            const bool last = (t == nt - 2);
            const char* a1 = cA + (size_t)(t + 1) * kstep;
            const char* a2 = last ? nA : cA + (size_t)(t + 2) * kstep; const char* b2 = last ? nB : cB + (size_t)(t + 2) * kstep;
            const char* a3 = a2 + kstep; const char* b3 = b2 + kstep;
            PG8_LDB(B0, 0, 0); PG8_LDB(B1, 0, 1); PG8_SCHED; PG8_LDA(At, 0, 0); PG8_STAGE(PG8_SA(1, 1), a1 + hstepA, voffA);
            PG8_WAIT_V(8); PG8_WAIT_L(0); PG8_BAR; PG8_MMA(0, 0, At, B0); PG8_MMA(0, 1, At, B1); PG8_BAR; PG8_SCHED;
            PG8_LDA(At, 0, 1); PG8_STAGE(PG8_SB(0, 0), b2, voffB); PG8_STAGE(PG8_SB(0, 1), b2 + hstepB, voffB); PG8_STAGE(PG8_SA(0, 0), a2, voffA);
            PG8_WAIT_V(8); PG8_WAIT_L(0); PG8_BAR; PG8_MMA(1, 0, At, B0); PG8_MMA(1, 1, At, B1); PG8_BAR; PG8_SCHED;
            PG8_LDB(B0, 1, 0); PG8_LDB(B1, 1, 1); PG8_SCHED; PG8_LDA(At, 1, 0); PG8_STAGE(PG8_SA(0, 1), a2 + hstepA, voffA);
            PG8_WAIT_V(8); PG8_WAIT_L(0); PG8_BAR; PG8_MMA(0, 0, At, B0); PG8_MMA(0, 1, At, B1); PG8_BAR; PG8_SCHED;
            PG8_LDA(At, 1, 1); PG8_STAGE(PG8_SB(1, 0), b3, voffB); PG8_STAGE(PG8_SB(1, 1), b3 + hstepB, voffB); PG8_STAGE(PG8_SA(1, 0), a3, voffA);
            PG8_WAIT_V(8); PG8_WAIT_L(0); PG8_BAR; PG8_MMA(1, 0, At, B0); PG8_MMA(1, 1, At, B1); PG8_BAR; PG8_SCHED;
        }
        if (wr == 0) PG8_BAR;
        E(acc, cur, wr, wc, fr, fq);
        if (!has_next) break;
#pragma unroll
        for (int a = 0; a < 2; ++a)
#pragma unroll
            for (int b = 0; b < 2; ++b)
#pragma unroll
                for (int m = 0; m < 4; ++m)
#pragma unroll
                    for (int n = 0; n < 2; ++n) acc[a][b][m][n] = (f32x4){0.f, 0.f, 0.f, 0.f};
        cur = nxt; cA = nA; cB = nB; ++ui;
        if (wr == 1) PG8_BAR;
    }
    PG8_WAIT_V(0);
    PG8_BAR;
#undef PG8_SA
#undef PG8_SB
#undef PG8_STAGE
#undef PG8_LDA
#undef PG8_LDB
#undef PG8_MMA
#undef PG8_WAIT_V
#undef PG8_WAIT_L
#undef PG8_BAR
#undef PG8_SCHED
}
}

#define LAS __attribute__((address_space(3)))
typedef unsigned short bf16;
typedef float f32x4 __attribute__((ext_vector_type(4)));
typedef float f32x16 __attribute__((ext_vector_type(16)));
typedef short bf16x8 __attribute__((ext_vector_type(8)));
typedef unsigned u32x4 __attribute__((ext_vector_type(4)));
typedef unsigned u32x2 __attribute__((ext_vector_type(2)));
using pg8::cvt_pk_bf16;
__device__ __forceinline__ float bf_lo(unsigned u) { return __uint_as_float(u << 16); }
__device__ __forceinline__ float bf_hi(unsigned u) { return __uint_as_float(u & 0xffff0000u); }
__device__ __forceinline__ float wave_sum(float v) {
#pragma unroll
    for (int o = 1; o < 64; o <<= 1) v += __shfl_xor(v, o);
    return v;
}

constexpr size_t MiB = 1u << 20;
constexpr size_t WS_WGU1 = 2 * MiB, WS_WD1 = 46 * MiB, WS_WGU2 = 68 * MiB, WS_WD2 = 112 * MiB, WS_WIN = 134 * MiB, WS_WQ = 147 * MiB + MiB / 2, WS_WK = 149 * MiB, WS_WV = 150 * MiB, WS_WOUT = 151 * MiB;
constexpr size_t WS_BAR = 1 * MiB;
constexpr size_t WS_SS = 0;
constexpr size_t WS_XB2 = 632 * MiB;
constexpr size_t WS_XN = 160 * MiB;
constexpr size_t WS_Y = WS_XN;
constexpr size_t WS_H = 288 * MiB;
constexpr size_t WS_Z = 288 * MiB;
constexpr size_t WS_QRAW = 496 * MiB;
constexpr size_t WS_KRAW = 632 * MiB;
constexpr size_t WS_VT = 696 * MiB;
constexpr int VT_LD = MTOK + 64;
constexpr size_t WS_Q = 761 * MiB;
constexpr size_t WS_K = 857 * MiB;
constexpr size_t WS_END = 953 * MiB;
static_assert(WS_WGU1 + (size_t)NGU * DM * 2 <= WS_WD1 && WS_WD1 + (size_t)DM * DFF * 2 <= WS_WGU2 && WS_WGU2 + (size_t)NGU * DM * 2 <= WS_WD2 && WS_WD2 + (size_t)DM * DFF * 2 <= WS_WIN, "ws map 1");
static_assert(WS_WIN + (size_t)ZLD * DM * 2 <= WS_WQ && WS_WQ + (size_t)QW * 512 * 2 <= WS_WK && WS_WK + 1024 * 512 * 2 <= WS_WV && WS_WV + 1024 * 512 * 2 <= WS_WOUT && WS_WOUT + (size_t)DM * DM * 2 <= WS_XN, "ws map 2");
static_assert(WS_XN + (size_t)MTOK * DM * 2 <= WS_H && WS_H + (size_t)MTOK * DFF * 2 <= WS_KRAW && WS_Z + (size_t)MTOK * ZLD * 2 <= WS_QRAW && WS_QRAW + (size_t)MTOK * QW * 2 <= WS_KRAW, "ws map 3");
static_assert(WS_KRAW + (size_t)MTOK * 1024 * 2 <= WS_VT && WS_VT + (size_t)VT_LD * 1024 * 2 <= WS_Q && WS_Q + (size_t)MTOK * QW * 2 <= WS_K && WS_K + (size_t)MTOK * QW * 2 <= WS_END, "ws map 4");

__device__ __forceinline__ unsigned f2bf(float f) { unsigned u = __builtin_bit_cast(unsigned, f); return (u + 0x7fffu + ((u >> 16) & 1u)) >> 16; }
__device__ __forceinline__ unsigned pk2(float lo, float hi) { return f2bf(lo) | (f2bf(hi) << 16); }
__device__ __forceinline__ void transpose_item(const float* W, int N, bf16* dst  , int K, int k0, int n0, LAS float* scr, int lane, const float* gk  ) {
    float wv[32];
#pragma unroll
    for (int i = 0; i < 32; ++i) { const int kk = 2 * i + (lane >> 5); wv[i] = W[(size_t)(k0 + kk) * N + n0 + (lane & 31)]; }
    if (gk) {
#pragma unroll
        for (int i = 0; i < 32; ++i) wv[i] *= gk[k0 + 2 * i + (lane >> 5)];
    }
#pragma unroll
    for (int i = 0; i < 32; ++i) { const int kk = 2 * i + (lane >> 5); scr[kk * 33 + (lane & 31)] = wv[i]; }
    asm volatile("s_waitcnt lgkmcnt(0)" ::: "memory");
    const int c = lane & 7;
#pragma unroll
    for (int j = 0; j < 4; ++j) { const int n = (lane >> 3) + 8 * j; const LAS float* s = scr + (8 * c) * 33 + n;
        u32x4 o; o.x = pk2(s[0 * 33], s[1 * 33]); o.y = pk2(s[2 * 33], s[3 * 33]); o.z = pk2(s[4 * 33], s[5 * 33]); o.w = pk2(s[6 * 33], s[7 * 33]);
        *(u32x4*)(dst + (size_t)n * K + k0 + 8 * c) = o; }
    asm volatile("s_waitcnt lgkmcnt(0)" ::: "memory");
}
__device__ __forceinline__ void rms_row_to_bf16(const float* xrow, const float* g, bf16* orow, int lane) {
    const f32x4* xr = (const f32x4*)xrow + lane; const f32x4* gr = (const f32x4*)g + lane;
    f32x4 v[8]; float s = 0.f;
#pragma unroll
    for (int j = 0; j < 8; ++j) { v[j] = xr[64 * j]; s += (v[j].x * v[j].x + v[j].y * v[j].y) + (v[j].z * v[j].z + v[j].w * v[j].w); }
    const float r = 1.0f / sqrtf(wave_sum(s) * (1.0f / DM) + EPS);
    u32x2* o8 = (u32x2*)orow + lane;
#pragma unroll
    for (int j = 0; j < 8; ++j) { const f32x4 gg = gr[64 * j]; u32x2 w; w.x = cvt_pk_bf16(v[j].x * r * gg.x, v[j].y * r * gg.y); w.y = cvt_pk_bf16(v[j].z * r * gg.z, v[j].w * r * gg.w); o8[64 * j] = w; }
}

__device__ __forceinline__ void p0_weights(LAS unsigned char* lds, unsigned char* ws, const float* wg1, const float* wu1, const float* wd1, const float* wg2, const float* wu2, const float* wd2,
                                           const float* win, const float* wq, const float* wkv, const float* wout, const float* g_mix, const float* g_ffn2, const float* g_q, const float* g_kv, int gw, int NGW, int wave, int lane,
                                           int lo1, int hi1, int lo2, int hi2, int lo3, int hi3  ) {
    LAS float* scr = (LAS float*)(lds + wave * 8448);
    constexpr int I_F = (DM / 64) * (DFF / 32), I_IN = (DM / 64) * (3136 / 32), I_Q = (512 / 64) * (QW / 32), I_KV = (512 / 64) * (2048 / 32);
    const int n1 = hi1 - lo1, n2 = hi2 - lo2, n3 = hi3 - lo3;
    for (int it = gw; it < n1 + n2 + n3; it += NGW) {
        int r = (it < n1) ? lo1 + it : (it < n1 + n2) ? lo2 + (it - n1) : lo3 + (it - n1 - n2);
        if (r < 6 * I_F) {
            const int which = r / I_F; r -= which * I_F; const int ffn = which / 3, kind = which % 3;
            if (kind < 2) { const float* W = wg1; if (which == 1) W = wu1; if (which == 3) W = wg2; if (which == 4) W = wu2; bf16* D = (bf16*)(ws + (ffn ? WS_WGU2 : WS_WGU1));
                const int nblk = DFF / 32, kb = r / nblk, nb = r % nblk, n0 = nb * 32; const int drow = (n0 / 128) * 256 + (n0 % 128) + kind * 128;
                transpose_item(W, DFF, D + (size_t)drow * DM, DM, kb * 64, n0, scr, lane, ffn ? g_ffn2 : nullptr); }
            else { const float* W = wd1; if (ffn) W = wd2; bf16* D = (bf16*)(ws + (ffn ? WS_WD2 : WS_WD1));
                const int nblk = DM / 32, kb = r / nblk, nb = r % nblk, n0 = nb * 32;
                transpose_item(W, DM, D + (size_t)n0 * DFF, DFF, kb * 64, n0, scr, lane, nullptr); }
            continue;
        }
        r -= 6 * I_F;
        if (r < I_IN) { const int nblk = 3136 / 32, kb = r / nblk, nb = r % nblk, n0 = nb * 32; transpose_item(win, 3136, (bf16*)(ws + WS_WIN) + (size_t)n0 * DM, DM, kb * 64, n0, scr, lane, g_mix); continue; }
        r -= I_IN;
        if (r < I_Q) { const int nblk = QW / 32, kb = r / nblk, nb = r % nblk, n0 = nb * 32; transpose_item(wq, QW, (bf16*)(ws + WS_WQ) + (size_t)n0 * 512, 512, kb * 64, n0, scr, lane, g_q); continue; }
        r -= I_Q;
        if (r < I_KV) { const int nblk = 2048 / 32, kb = r / nblk, nb = r % nblk, n0 = nb * 32; const int h = n0 >> 8, c = n0 & 255;
            bf16* D = (c < 128) ? (bf16*)(ws + WS_WK) + (size_t)(h * 128 + c) * 512 : (bf16*)(ws + WS_WV) + (size_t)(h * 128 + c - 128) * 512;
            transpose_item(wkv, 2048, D, 512, kb * 64, n0, scr, lane, g_kv); continue; }
        r -= I_KV;
        { const int nblk = DM / 32, kb = r / nblk, nb = r % nblk, n0 = nb * 32; transpose_item(wout, DM, (bf16*)(ws + WS_WOUT) + (size_t)n0 * DM, DM, kb * 64, n0, scr, lane, nullptr); }
    }
}

__device__ __forceinline__ void p0_zero(unsigned char* ws, int gw, int NGW, int lane) {
    { float* ssz = (float*)(ws + WS_SS); for (int i = gw * 64 + lane; i < 5 * MTOK; i += NGW * 64) ssz[i] = 0.f; }
    { u32x4* z = (u32x4*)((bf16*)(ws + WS_WIN) + (size_t)3136 * DM); const int n16 = (ZLD - 3136) * DM * 2 / 16;
      for (int i = gw * 64 + lane; i < n16; i += NGW * 64) z[i] = (u32x4){0u, 0u, 0u, 0u}; }
}

__device__ __forceinline__ void znorm_seg16(bf16* p, const float* g, float invn, int lane, int nvec  ) {
    u32x4 a[2]; float s = 0.f;
#pragma unroll
    for (int j = 0; j < 2; ++j) if (j < nvec) { a[j] = *(const u32x4*)(p + j * 512 + lane * 8);
#pragma unroll
        for (int k = 0; k < 4; ++k) { const float lo = bf_lo(a[j][k]), hi = bf_hi(a[j][k]); s += lo * lo + hi * hi; } }
    const float r = 1.0f / sqrtf(wave_sum(s) * invn + EPS);
#pragma unroll
    for (int j = 0; j < 2; ++j) if (j < nvec) { const f32x4 g0 = *(const f32x4*)(g + j * 512 + lane * 8), g1 = *(const f32x4*)(g + j * 512 + lane * 8 + 4); u32x4 w;
        w.x = cvt_pk_bf16(bf_lo(a[j].x) * r * g0.x, bf_hi(a[j].x) * r * g0.y); w.y = cvt_pk_bf16(bf_lo(a[j].y) * r * g0.z, bf_hi(a[j].y) * r * g0.w);
        w.z = cvt_pk_bf16(bf_lo(a[j].z) * r * g1.x, bf_hi(a[j].z) * r * g1.y); w.w = cvt_pk_bf16(bf_lo(a[j].w) * r * g1.z, bf_hi(a[j].w) * r * g1.w);
        *(u32x4*)(p + j * 512 + lane * 8) = w; }
}

__device__ const double ROPE_REV[32] = {0.15915494309189535, 0.11934937021124886, 0.08949940160889101, 0.06711508300522726, 0.050329212104487035, 0.03774158471741977, 0.0283021958306234, 0.02122365276477766,
    0.015915494309189534, 0.011934937021124886, 0.008949940160889102, 0.006711508300522725, 0.005032921210448704, 0.003774158471741977, 0.00283021958306234, 0.0021223652764777662,
    0.0015915494309189536, 0.0011934937021124885, 0.0008949940160889102, 0.0006711508300522726, 0.0005032921210448703, 0.00037741584717419774, 0.00028302195830623395, 0.0002122365276477766,
    0.00015915494309189535, 0.00011934937021124886, 8.949940160889102e-05, 6.711508300522725e-05, 5.0329212104487035e-05, 3.774158471741978e-05, 2.8302195830623396e-05, 2.122365276477766e-05};
constexpr float QSCALE = 0.07216878364870322f * 1.4426950408889634f;
struct QKIn { u32x4 a0, a1; u32x2 r1, r2; };
__device__ __forceinline__ QKIn qk_load(const bf16* nope, const bf16* rope, int j) {
    QKIn q; q.a0 = *(const u32x4*)(nope + 16 * j); q.a1 = *(const u32x4*)(nope + 16 * j + 8); q.r1 = *(const u32x2*)(rope + 4 * j); q.r2 = *(const u32x2*)(rope + 32 + 4 * j); return q;
}
__device__ __forceinline__ void qk_finish(const QKIn& in, const float* g, bf16* dst, const float (&cs)[4], const float (&sn)[4], int j, float oscale) {
    const u32x4 a0 = in.a0, a1 = in.a1; const u32x2 r1 = in.r1, r2 = in.r2;
    float x[16], y1[4], y2[4];
#pragma unroll
    for (int k = 0; k < 4; ++k) { x[2 * k] = bf_lo(a0[k]); x[2 * k + 1] = bf_hi(a0[k]); x[8 + 2 * k] = bf_lo(a1[k]); x[8 + 2 * k + 1] = bf_hi(a1[k]); }
    y1[0] = bf_lo(r1.x); y1[1] = bf_hi(r1.x); y1[2] = bf_lo(r1.y); y1[3] = bf_hi(r1.y);
    y2[0] = bf_lo(r2.x); y2[1] = bf_hi(r2.x); y2[2] = bf_lo(r2.y); y2[3] = bf_hi(r2.y);
    float s = 0.f;
#pragma unroll
    for (int k = 0; k < 16; ++k) s += x[k] * x[k];
#pragma unroll
    for (int k = 0; k < 4; ++k) s += y1[k] * y1[k] + y2[k] * y2[k];
    s += __shfl_xor(s, 1); s += __shfl_xor(s, 2); s += __shfl_xor(s, 4);
    const float r = 1.0f / sqrtf(s * (1.0f / QKD) + EPS);
    const f32x4 g0 = *(const f32x4*)(g + 16 * j), g1 = *(const f32x4*)(g + 16 * j + 4), g2 = *(const f32x4*)(g + 16 * j + 8), g3 = *(const f32x4*)(g + 16 * j + 12);
    const f32x4 ga = *(const f32x4*)(g + 128 + 4 * j), gb = *(const f32x4*)(g + 160 + 4 * j);
    const float ro = r * oscale;
    u32x4 w0, w1;
    w0.x = cvt_pk_bf16(x[0] * ro * g0.x, x[1] * ro * g0.y); w0.y = cvt_pk_bf16(x[2] * ro * g0.z, x[3] * ro * g0.w); w0.z = cvt_pk_bf16(x[4] * ro * g1.x, x[5] * ro * g1.y); w0.w = cvt_pk_bf16(x[6] * ro * g1.z, x[7] * ro * g1.w);
    w1.x = cvt_pk_bf16(x[8] * ro * g2.x, x[9] * ro * g2.y); w1.y = cvt_pk_bf16(x[10] * ro * g2.z, x[11] * ro * g2.w); w1.z = cvt_pk_bf16(x[12] * ro * g3.x, x[13] * ro * g3.y); w1.w = cvt_pk_bf16(x[14] * ro * g3.z, x[15] * ro * g3.w);
    *(u32x4*)(dst + 16 * j) = w0; *(u32x4*)(dst + 16 * j + 8) = w1;
    float o1[4], o2[4];
#pragma unroll
    for (int k = 0; k < 4; ++k) { const float a = y1[k] * r * ga[k], b = y2[k] * r * gb[k]; o1[k] = (a * cs[k] - b * sn[k]) * oscale; o2[k] = (b * cs[k] + a * sn[k]) * oscale; }
    u32x2 v1, v2; v1.x = cvt_pk_bf16(o1[0], o1[1]); v1.y = cvt_pk_bf16(o1[2], o1[3]); v2.x = cvt_pk_bf16(o2[0], o2[1]); v2.y = cvt_pk_bf16(o2[2], o2[3]);
    *(u32x2*)(dst + 128 + 4 * j) = v1; *(u32x2*)(dst + 160 + 4 * j) = v2;
}
__device__ __forceinline__ void rope_cs(int pos, int j, float (&cs)[4], float (&sn)[4]) {
#pragma unroll
    for (int k = 0; k < 4; ++k) { const double rev = (double)pos * ROPE_REV[4 * j + k]; const float fr = (float)(rev - __builtin_floor(rev)); cs[k] = __builtin_amdgcn_cosf(fr); sn[k] = __builtin_amdgcn_sinf(fr); }
}
__device__ __forceinline__ void qk_token2(int t0, int t1, const int* positions, const bf16* Qraw, const bf16* Kraw, const bf16* Z, const float* qg, const float* kg, bf16* Q, bf16* K, int lane) {
    const int h = lane >> 3, j = lane & 7; const int p0 = positions[t0], p1 = positions[t1];
    const QKIn q0 = qk_load(Qraw + (size_t)t0 * QW + h * QKD, Qraw + (size_t)t0 * QW + h * QKD + 128, j), k0 = qk_load(Kraw + (size_t)t0 * 1024 + h * 128, Z + (size_t)t0 * ZLD + 3072, j);
    const QKIn q1 = qk_load(Qraw + (size_t)t1 * QW + h * QKD, Qraw + (size_t)t1 * QW + h * QKD + 128, j), k1 = qk_load(Kraw + (size_t)t1 * 1024 + h * 128, Z + (size_t)t1 * ZLD + 3072, j);
    float cs[4], sn[4];
    rope_cs(p0, j, cs, sn);
    qk_finish(q0, qg, Q + (size_t)t0 * QW + h * QKD, cs, sn, j, QSCALE); qk_finish(k0, kg, K + (size_t)t0 * QW + h * QKD, cs, sn, j, 1.0f);
    rope_cs(p1, j, cs, sn);
    qk_finish(q1, qg, Q + (size_t)t1 * QW + h * QKD, cs, sn, j, QSCALE); qk_finish(k1, kg, K + (size_t)t1 * QW + h * QKD, cs, sn, j, 1.0f);
}

namespace att {
constexpr int KP = 400, VP = 144, KBYTES = 64 * KP, VBYTES = 128 * VP, STAGE = KBYTES + VBYTES;
#define MFMA32(a, b, c) __builtin_amdgcn_mfma_f32_32x32x16_bf16((a), (b), (c), 0, 0, 0)
__device__ __forceinline__ void attn_unit(LAS unsigned char* lds, const bf16* Q, const bf16* K, const bf16* Vt, bf16* Y, const float* gout, int b, int h, int qb, const int tid) {
    const int lane = tid & 63, r32 = lane & 31, hi = lane >> 5; const int wid = __builtin_amdgcn_readfirstlane(tid >> 6);
    const int q0 = qb * 256, qrow = q0 + wid * 32 + r32;
    const size_t tok0 = (size_t)b * SEQ;
    bf16x8 qf[12];
    { const bf16* qp = Q + (tok0 + qrow) * QW + h * QKD + hi * 8;
#pragma unroll
      for (int dk = 0; dk < 12; ++dk) qf[dk] = *(const bf16x8*)(qp + dk * 16); }
    const bf16* ksrc = K + (tok0 + (tid >> 3)) * QW + h * QKD + (tid & 7) * 8;
    const unsigned kdst = (tid >> 3) * KP + (tid & 7) * 16;
    const bf16* vsrc = Vt + (size_t)(h * VD + (tid >> 2)) * VT_LD + tok0 + (tid & 3) * 8;
    const unsigned vdst = KBYTES + (tid >> 2) * VP + (tid & 3) * 16;
    const int NT = 4 * (qb + 1), my_last = 4 * qb + (wid >> 1);
    u32x4 kr[3], vr[2];
#pragma unroll
    for (int i = 0; i < 3; ++i) kr[i] = *(const u32x4*)(ksrc + i * 64);
#pragma unroll
    for (int i = 0; i < 2; ++i) vr[i] = *(const u32x4*)(vsrc + i * 32);
    __syncthreads();
#pragma unroll
    for (int i = 0; i < 3; ++i) *(LAS u32x4*)(lds + kdst + i * 128) = kr[i];
#pragma unroll
    for (int i = 0; i < 2; ++i) *(LAS u32x4*)(lds + vdst + i * 64) = vr[i];
    __syncthreads();
    const int pim = (r32 & 16) + ((r32 >> 2) & 1) * 8 + ((r32 >> 3) & 1) * 4 + (r32 & 3);
    const unsigned koff = pim * KP + hi * 16, voff = KBYTES + r32 * VP + hi * 16;
    f32x16 o[4];
#pragma unroll
    for (int d = 0; d < 4; ++d)
#pragma unroll
        for (int r = 0; r < 16; ++r) o[d][r] = 0.f;
    float m_run = -1e30f, l_run = 0.f;
    for (int t = 0; t < NT; ++t) {
        const unsigned bo = (t & 1) * STAGE;
        const bool more = (t + 1 < NT);
        if (more) {
#pragma unroll
            for (int i = 0; i < 3; ++i) kr[i] = *(const u32x4*)(ksrc + (size_t)(t + 1) * 64 * QW + i * 64);
#pragma unroll
            for (int i = 0; i < 2; ++i) vr[i] = *(const u32x4*)(vsrc + (t + 1) * 64 + i * 32);
        }
        if (t <= my_last) {
            f32x16 s0, s1;
#pragma unroll
            for (int r = 0; r < 16; ++r) { s0[r] = 0.f; s1[r] = 0.f; }
#pragma unroll
            for (int dk = 0; dk < 12; ++dk) {
                const bf16x8 k0 = *(const LAS bf16x8*)(lds + bo + koff + dk * 32), k1 = *(const LAS bf16x8*)(lds + bo + koff + 32 * KP + dk * 32);
                s0 = MFMA32(k0, qf[dk], s0); s1 = MFMA32(k1, qf[dk], s1);
            }
            if (t >= 4 * qb) {
                const int kb0 = 64 * t + 8 * hi;
#pragma unroll
                for (int r = 0; r < 16; ++r) { const int key = kb0 + 16 * (r >> 3) + (r & 7); if (key > qrow) s0[r] = -1e30f; if (key + 32 > qrow) s1[r] = -1e30f; }
            }
            float mx = s0[0];
#pragma unroll
            for (int r = 1; r < 16; ++r) mx = fmaxf(mx, s0[r]);
#pragma unroll
            for (int r = 0; r < 16; ++r) mx = fmaxf(mx, s1[r]);
            mx = fmaxf(mx, __shfl_xor(mx, 32));
            const float m_new = fmaxf(m_run, mx), alpha = __builtin_amdgcn_exp2f(m_run - m_new);
            m_run = m_new;
            float ls = 0.f;
#pragma unroll
            for (int r = 0; r < 16; ++r) { s0[r] = __builtin_amdgcn_exp2f(s0[r] - m_new); s1[r] = __builtin_amdgcn_exp2f(s1[r] - m_new); ls += s0[r] + s1[r]; }
            l_run = l_run * alpha + ls;
#pragma unroll
            for (int d = 0; d < 4; ++d)
#pragma unroll
                for (int r = 0; r < 16; ++r) o[d][r] *= alpha;
            u32x4 pw[4];
#pragma unroll
            for (int c = 0; c < 2; ++c) {
                pw[c] = (u32x4){cvt_pk_bf16(s0[8 * c], s0[8 * c + 1]), cvt_pk_bf16(s0[8 * c + 2], s0[8 * c + 3]), cvt_pk_bf16(s0[8 * c + 4], s0[8 * c + 5]), cvt_pk_bf16(s0[8 * c + 6], s0[8 * c + 7])};
                pw[2 + c] = (u32x4){cvt_pk_bf16(s1[8 * c], s1[8 * c + 1]), cvt_pk_bf16(s1[8 * c + 2], s1[8 * c + 3]), cvt_pk_bf16(s1[8 * c + 4], s1[8 * c + 5]), cvt_pk_bf16(s1[8 * c + 6], s1[8 * c + 7])};
            }
#pragma unroll
            for (int kc = 0; kc < 4; ++kc) {
                const bf16x8 pf = __builtin_bit_cast(bf16x8, pw[kc]);
#pragma unroll
                for (int d = 0; d < 4; ++d) { const bf16x8 vf = *(const LAS bf16x8*)(lds + bo + voff + d * 32 * VP + kc * 32); o[d] = MFMA32(vf, pf, o[d]); }
            }
        }
        if (more) {
            const unsigned nb = ((t + 1) & 1) * STAGE;
#pragma unroll
            for (int i = 0; i < 3; ++i) *(LAS u32x4*)(lds + nb + kdst + i * 128) = kr[i];
#pragma unroll
            for (int i = 0; i < 2; ++i) *(LAS u32x4*)(lds + nb + vdst + i * 64) = vr[i];
        }
        __syncthreads();
    }
    const float l = l_run + __shfl_xor(l_run, 32), inv = 1.0f / l;
    float ss = 0.f;
#pragma unroll
    for (int d = 0; d < 4; ++d)
#pragma unroll
        for (int r = 0; r < 16; ++r) { o[d][r] *= inv; ss += o[d][r] * o[d][r]; }
    ss += __shfl_xor(ss, 32);
    const float rn = 1.0f / sqrtf(ss * (1.0f / VD) + EPS);
    bf16* yp = Y + (tok0 + qrow) * DM + 1024 + h * VD + 4 * hi; const float* gp = gout + h * VD + 4 * hi;
#pragma unroll
    for (int d = 0; d < 4; ++d)
#pragma unroll
        for (int r4 = 0; r4 < 4; ++r4) { const f32x4 g = *(const f32x4*)(gp + 32 * d + 8 * r4); u32x2 w;
            w.x = cvt_pk_bf16(o[d][4 * r4] * rn * g.x, o[d][4 * r4 + 1] * rn * g.y); w.y = cvt_pk_bf16(o[d][4 * r4 + 2] * rn * g.z, o[d][4 * r4 + 3] * rn * g.w);
            *(u32x2*)(yp + 32 * d + 8 * r4) = w; }
}
}

namespace gm {
constexpr int WP = 272;
constexpr int WBYTES = 128 * WP;
__device__ __forceinline__ void gmlp_phase(LAS unsigned char* lds, const bf16* Z, const float* w_s, const float* b_s, const float* gout, const float* ssv, const float* gv, bf16* Y, int vcu, int G, const int tid) {
    const int lane = tid & 63, l16 = lane & 15, q4 = lane >> 4; const int wid = __builtin_amdgcn_readfirstlane(tid >> 6);
    int gcur = -1;
    u32x4 vreg[4]; float rvreg[4];
    if (vcu < 2048) { const int g = vcu & 7; const size_t tok0 = (size_t)(vcu >> 3) * 128;
#pragma unroll
        for (int i = 0; i < 4; ++i) { const int p = tid + 512 * i, s = p >> 4, seg = p & 15; vreg[i] = *(const u32x4*)(Z + (tok0 + s) * ZLD + 1024 + g * 128 + seg * 8); rvreg[i] = ssv[tok0 + s]; } }
    for (int un = vcu; un < 2048; un += G) {
        const int g = un & 7, bc = un >> 3;
        const size_t tok0 = (size_t)bc * 128;
        __syncthreads();
        if (g != gcur) {
            gcur = g;
#pragma unroll
            for (int i = 0; i < 8; ++i) { const int p = tid + 512 * i, t = p >> 5, s = (p & 31) * 4; const f32x4 w = *(const f32x4*)(w_s + (size_t)g * 16384 + t * 128 + s);
                u32x2 o; o.x = cvt_pk_bf16(s <= t ? w.x : 0.f, s + 1 <= t ? w.y : 0.f); o.y = cvt_pk_bf16(s + 2 <= t ? w.z : 0.f, s + 3 <= t ? w.w : 0.f);
                *(LAS u32x2*)(lds + t * WP + s * 2) = o; }
        }
#pragma unroll
        for (int i = 0; i < 4; ++i) { const int p = tid + 512 * i, s = p >> 4, seg = p & 15; const u32x4 v = vreg[i];
            const float rv = __builtin_amdgcn_rsqf(rvreg[i] * (1.0f / 1024.0f) + EPS); const f32x4 g0 = *(const f32x4*)(gv + g * 128 + seg * 8), g1 = *(const f32x4*)(gv + g * 128 + seg * 8 + 4);
            LAS unsigned short* dst = (LAS unsigned short*)(lds + WBYTES + (seg * 8) * WP + s * 2);
            const unsigned w0 = cvt_pk_bf16(bf_lo(v.x) * rv * g0.x, bf_hi(v.x) * rv * g0.y), w1 = cvt_pk_bf16(bf_lo(v.y) * rv * g0.z, bf_hi(v.y) * rv * g0.w);
            const unsigned w2 = cvt_pk_bf16(bf_lo(v.z) * rv * g1.x, bf_hi(v.z) * rv * g1.y), w3 = cvt_pk_bf16(bf_lo(v.w) * rv * g1.z, bf_hi(v.w) * rv * g1.w);
            dst[0 * (WP / 2)] = (unsigned short)(w0 & 0xffffu); dst[1 * (WP / 2)] = (unsigned short)(w0 >> 16); dst[2 * (WP / 2)] = (unsigned short)(w1 & 0xffffu); dst[3 * (WP / 2)] = (unsigned short)(w1 >> 16);
            dst[4 * (WP / 2)] = (unsigned short)(w2 & 0xffffu); dst[5 * (WP / 2)] = (unsigned short)(w2 >> 16); dst[6 * (WP / 2)] = (unsigned short)(w3 & 0xffffu); dst[7 * (WP / 2)] = (unsigned short)(w3 >> 16); }
        if (un + G < 2048) { const int gn = (un + G) & 7; const size_t tokn = (size_t)((un + G) >> 3) * 128;
#pragma unroll
            for (int i = 0; i < 4; ++i) { const int p = tid + 512 * i, s = p >> 4, seg = p & 15; vreg[i] = *(const u32x4*)(Z + (tokn + s) * ZLD + 1024 + gn * 128 + seg * 8); rvreg[i] = ssv[tokn + s]; } }
        const int tt = 16 * wid + l16; const float bs = b_s[g * 128 + tt];
        const bf16* up = Z + (tok0 + tt) * ZLD + g * 128 + 4 * q4;
        u32x2 ureg[8];
#pragma unroll
        for (int d = 0; d < 8; ++d) ureg[d] = *(const u32x2*)(up + 16 * d);
        __syncthreads();
        pg8::f32x4 acc[8];
#pragma unroll
        for (int d = 0; d < 8; ++d) acc[d] = (pg8::f32x4){0.f, 0.f, 0.f, 0.f};
        const int nsb = (wid >> 1) + 1;
        for (int sb = 0; sb < nsb; ++sb) {
            const bf16x8 wf = *(const LAS bf16x8*)(lds + (16 * wid + l16) * WP + sb * 64 + q4 * 16);
#pragma unroll
            for (int d = 0; d < 8; ++d) { const bf16x8 vf = *(const LAS bf16x8*)(lds + WBYTES + (16 * d + l16) * WP + sb * 64 + q4 * 16); acc[d] = __builtin_amdgcn_mfma_f32_16x16x32_bf16(vf, wf, acc[d], 0, 0, 0); }
        }
        const int t = tt;
        float ss = 0.f;
#pragma unroll
        for (int d = 0; d < 8; ++d) { const u32x2 uu = ureg[d];
            acc[d][0] = bf_lo(uu.x) * (acc[d][0] + bs); acc[d][1] = bf_hi(uu.x) * (acc[d][1] + bs); acc[d][2] = bf_lo(uu.y) * (acc[d][2] + bs); acc[d][3] = bf_hi(uu.y) * (acc[d][3] + bs);
            ss += (acc[d][0] * acc[d][0] + acc[d][1] * acc[d][1]) + (acc[d][2] * acc[d][2] + acc[d][3] * acc[d][3]); }
        ss += __shfl_xor(ss, 16); ss += __shfl_xor(ss, 32);
        const float rn = 1.0f / sqrtf(ss * (1.0f / 128.0f) + EPS);
        bf16* yp = Y + (tok0 + t) * DM + g * 128 + 4 * q4; const float* gp = gout + g * 128 + 4 * q4;
#pragma unroll
        for (int d = 0; d < 8; ++d) { const f32x4 gg = *(const f32x4*)(gp + 16 * d); u32x2 w; w.x = cvt_pk_bf16(acc[d][0] * rn * gg.x, acc[d][1] * rn * gg.y); w.y = cvt_pk_bf16(acc[d][2] * rn * gg.z, acc[d][3] * rn * gg.w);
            *(u32x2*)(yp + 16 * d) = w; }
    }
}
}

#define XB_TMO      128
#define XB_XCNT(j)  (256  + 64 * (j))
#define XB_XSUB(j)  (1280 + 64 * (j))
#define XB_XGEN(j)  (2304 + 64 * (j))
#define XB_TOP      3328
#define XB_TOPGEN   3392
#define XCD_BAR_WORDS 3456
#define XB_SPIN_CAP (1u << 18)

__device__ __forceinline__ unsigned xb_ld(unsigned* p)              { return __hip_atomic_load(p, __ATOMIC_RELAXED, __HIP_MEMORY_SCOPE_AGENT); }
__device__ __forceinline__ unsigned xb_add(unsigned* p, unsigned v) { return __hip_atomic_fetch_add(p, v, __ATOMIC_RELAXED, __HIP_MEMORY_SCOPE_AGENT); }
__device__ __forceinline__ unsigned xb_xcc_id() { return (unsigned)__builtin_amdgcn_s_getreg((3 << 11) | 20) & 0xFu; }
#define XB_SPIN(cond, bar) do { unsigned _sp = 0; while (cond) { __builtin_amdgcn_s_sleep(1); \
    if ((++_sp & 255u) == 0u) { if (xb_ld(&(bar)[XB_TMO])) break; if (_sp > XB_SPIN_CAP) { atomicAdd(&(bar)[XB_TMO], 1u); break; } } } } while (0)

struct XcdBarrier {
    unsigned* bar; unsigned x;
    volatile LAS unsigned* st;
};

__device__ __forceinline__ XcdBarrier xcd_barrier_post(unsigned* bar, volatile LAS unsigned* st) {
    XcdBarrier b; b.bar = bar; b.x = xb_xcc_id(); b.st = st;
    if (threadIdx.x == 0) (void)xb_add(&bar[XB_XCNT(b.x)], 1u);
    return b;
}
__device__ __forceinline__ void xcd_barrier_complete(unsigned* bar, unsigned x, unsigned& nloc, unsigned& nx) {
    const unsigned G = gridDim.x * gridDim.y * gridDim.z;
    unsigned sum, cnt, mine, sp = 0u;
    for (;;) {
        sum = 0u; cnt = 0u; mine = 0u;
#pragma unroll
        for (unsigned j = 0; j < 16; ++j) { const unsigned c = xb_ld(&bar[XB_XCNT(j)]); sum += c; cnt += (c > 0u) ? 1u : 0u; mine = (j == x) ? c : mine; }
        if (sum == G) break;
        __builtin_amdgcn_s_sleep(1);
        if ((++sp & 255u) == 0u) { if (xb_ld(&bar[XB_TMO])) break; if (sp > XB_SPIN_CAP) { atomicAdd(&bar[XB_TMO], 1u); break; } }
    }
    nloc = mine > 0u ? mine : 1u; nx = cnt > 0u ? cnt : 1u;
}

__device__ __forceinline__ void xcd_barrier(const XcdBarrier& b) {
    asm volatile("s_waitcnt vmcnt(0)" ::: "memory");
    __syncthreads();
    if (threadIdx.x == 0) {
        unsigned* bar = b.bar;
        __builtin_amdgcn_s_waitcnt(0);
        unsigned nloc = b.st[0], nx = b.st[1];
        if (nloc == 0u) { xcd_barrier_complete(bar, b.x, nloc, nx); b.st[0] = nloc; b.st[1] = nx; }
        const unsigned old = xb_add(&bar[XB_XSUB(b.x)], 1u);
        const unsigned gen = old / nloc;
        if (old + 1u == (gen + 1u) * nloc) {
            __builtin_amdgcn_fence(__ATOMIC_RELEASE, "agent");
            asm volatile("s_waitcnt vmcnt(0)" ::: "memory");
            const unsigned og = xb_add(&bar[XB_TOP], 1u);
            const unsigned tg = og / nx;
            if (og + 1u == (tg + 1u) * nx) xb_add(&bar[XB_TOPGEN], 1u);
            else XB_SPIN(xb_ld(&bar[XB_TOPGEN]) == tg, bar);
            __builtin_amdgcn_fence(__ATOMIC_ACQUIRE, "agent");
            xb_add(&bar[XB_XGEN(b.x)], 1u);
            asm volatile("s_waitcnt vmcnt(0)" ::: "memory");
        } else {
            XB_SPIN(xb_ld(&bar[XB_XGEN(b.x)]) == gen, bar);
            __builtin_amdgcn_fence(__ATOMIC_ACQUIRE, "agent");
            asm volatile("s_waitcnt vmcnt(0)" ::: "memory");
        }
    }
    __syncthreads();
}

constexpr int LDS_BYTES = 147456;
constexpr int NPHASE = 10;
constexpr int I_F = (DM / 64) * (DFF / 32), I_IN = (DM / 64) * (3136 / 32), I_Q = (512 / 64) * (QW / 32), I_KV = (512 / 64) * (2048 / 32), I_O = (DM / 64) * (DM / 32);
#ifndef DUP_MASK
#define DUP_MASK 0
#endif
struct Args { const float* in[24]; float* out; unsigned char* ws; int ph_lo, ph_hi; };
static_assert(offsetof(Args, out) == 192 && offsetof(Args, ws) == 200, "kernarg offsets");

__global__ void __launch_bounds__(512, 2) fwd_megakernel(Args a) {
    extern __shared__ __attribute__((aligned(16))) unsigned char lds_raw[];
    LAS unsigned char* lds = (LAS unsigned char*)lds_raw;
    cg::grid_group grid = cg::this_grid();
    volatile LAS unsigned* MISC = (volatile LAS unsigned*)(lds + 131072 + 512);
    if (threadIdx.x < 4) MISC[threadIdx.x] = 0u;
    __syncthreads();
    const XcdBarrier bar = xcd_barrier_post((unsigned*)(a.ws + WS_BAR), MISC);
    const int G = gridDim.x, bx = blockIdx.x; const int vcu = (G % 8 == 0) ? (bx % 8) * (G / 8) + bx / 8 : bx;
    const int NGW = G * 8;
    for (int ph = a.ph_lo; ph < a.ph_hi; ++ph) {
    int rep = 0;
phase_again:
    int tid = threadIdx.x; asm volatile("" : "+v"(tid));
    const __attribute__((address_space(4))) char* kp = (const __attribute__((address_space(4))) char*)__builtin_amdgcn_kernarg_segment_ptr(); asm volatile("" : "+s"(kp));
#define KIN(i) (*(const float* const __attribute__((address_space(4)))*)(kp + 8 * (i)))
    unsigned char* ws = *(unsigned char* const __attribute__((address_space(4)))*)(kp + 200); float* out = *(float* const __attribute__((address_space(4)))*)(kp + 192);
    const int lane = tid & 63, wave = __builtin_amdgcn_readfirstlane(tid >> 6), gw = vcu * 8 + wave;
    bf16* XN = (bf16*)(ws + WS_XN); bf16* Yb = (bf16*)(ws + WS_Y); bf16* H = (bf16*)(ws + WS_H); bf16* Z = (bf16*)(ws + WS_Z);
    bf16* QRAW = (bf16*)(ws + WS_QRAW); bf16* KRAW = (bf16*)(ws + WS_KRAW); bf16* VT = (bf16*)(ws + WS_VT); bf16* Qb = (bf16*)(ws + WS_Q); bf16* Kb = (bf16*)(ws + WS_K);
        const bool is_gemm = (ph == 1 || ph == 2 || ph == 3 || ph == 4 || ph == 7 || ph == 8 || ph == 9);
        float* SS = (float*)(ws + WS_SS); bf16* XB1 = (bf16*)out;
        if (is_gemm) {
            const int nsub = (ph == 4) ? 3 : 1;
            for (int sub = 0; sub < nsub; ++sub) {
                pg8::Gemm g; pg8::Epi E; E.mode = 0; E.O = nullptr; E.ldc = 0; E.base = nullptr; E.base_bf = nullptr; E.out = nullptr; E.alpha = 0.f; E.rs = nullptr; E.rs_invn = 1.0f / DM; E.xb = nullptr; E.ss_out = nullptr;
                if (ph == 1) { g = pg8::Gemm{XN, (const bf16*)(ws + WS_WGU1), MTOK, NGU, DM, DM, DM}; E.mode = 2; E.O = H; E.ldc = DFF; }
                else if (ph == 8) { g = pg8::Gemm{(const bf16*)(ws + WS_XB2), (const bf16*)(ws + WS_WGU2), MTOK, NGU, DM, DM, DM}; E.mode = 2; E.O = H; E.ldc = DFF; E.rs = SS + MTOK; }
                else if (ph == 2) { g = pg8::Gemm{H, (const bf16*)(ws + WS_WD1), MTOK, DM, DFF, DFF, DFF}; E.mode = 3; E.base = KIN(0); E.ldc = DM; E.alpha = 0.5f; E.xb = XB1; E.ss_out = SS; }
                else if (ph == 9) { g = pg8::Gemm{H, (const bf16*)(ws + WS_WD2), MTOK, DM, DFF, DFF, DFF}; E.mode = 3; E.base_bf = (const bf16*)(ws + WS_XB2); E.out = out; E.ldc = DM; E.alpha = 0.5f; }
                else if (ph == 3) { g = pg8::Gemm{XB1, (const bf16*)(ws + WS_WIN), MTOK, ZLD, DM, DM, DM}; E.mode = 1; E.O = Z; E.ldc = ZLD; E.rs = SS; E.ss_out = SS + 2 * MTOK; }
                else if (ph == 7) { g = pg8::Gemm{Yb, (const bf16*)(ws + WS_WOUT), MTOK, DM, DM, DM, DM}; E.mode = 3; E.base_bf = XB1; E.ldc = DM; E.alpha = 1.0f; E.xb = (bf16*)(ws + WS_XB2); E.ss_out = SS + MTOK; }
                else if (sub == 0) { g = pg8::Gemm{Z + 2048, (const bf16*)(ws + WS_WQ), MTOK, QW, 512, ZLD, 512}; E.O = QRAW; E.ldc = QW; E.rs = SS + 3 * MTOK; E.rs_invn = 1.0f / 512.0f; }
                else if (sub == 1) { g = pg8::Gemm{Z + 2560, (const bf16*)(ws + WS_WK), MTOK, 1024, 512, ZLD, 512}; E.O = KRAW; E.ldc = 1024; E.rs = SS + 4 * MTOK; E.rs_invn = 1.0f / 512.0f; }
                else { g = pg8::Gemm{(const bf16*)(ws + WS_WV), Z + 2560, 1024, MTOK, 512, 512, ZLD}; E.mode = 4; E.O = VT; E.ldc = VT_LD; E.rs = SS + 4 * MTOK; E.rs_invn = 1.0f / 512.0f; }
                pg8::StaticOrder S; S.init(g.M, g.N, G, bx, (ph == 2 || ph == 7 || ph == 9) ? 4 : 8);
#ifndef NO_GEMM
                pg8::gemm_phase(lds, g, S, E, tid);
#endif
            }
            if (ph == 1 || ph == 3 || ph == 8) {
                const int nwg_ = (MTOK / 256) * ((ph == 3 ? ZLD : NGU) / 256), rem = nwg_ % G;
                if (rem != 0 && bx >= rem) { const int gwi = (bx - rem) * 8 + wave, ngwi = (G - rem) * 8;
                    const int lo = (ph == 1) ? 2 * I_F : (ph == 8) ? 5 * I_F : 6 * I_F + I_IN, hi = (ph == 1) ? 3 * I_F : (ph == 8) ? 6 * I_F : 6 * I_F + I_IN + I_Q + I_KV + I_O;
                    p0_weights(lds, ws, KIN(3), KIN(4), KIN(5), KIN(21), KIN(22), KIN(23), KIN(7), KIN(12), KIN(14), KIN(19), KIN(6), KIN(20), KIN(11), KIN(13), gwi, ngwi, wave, lane, lo, hi, 0, 0, 0, 0); }
                else if (rem == 0 && ph != 3) {
                    const int lo = (ph == 1) ? 2 * I_F : 5 * I_F, hi = lo + I_F;
                    p0_weights(lds, ws, KIN(3), KIN(4), KIN(5), KIN(21), KIN(22), KIN(23), KIN(7), KIN(12), KIN(14), KIN(19), KIN(6), KIN(20), KIN(11), KIN(13), gw, NGW, wave, lane, lo, hi, 0, 0, 0, 0); }
                else if (rem == 0) { const int lo = 6 * I_F + I_IN, hi = lo + I_Q + I_KV + I_O;
                    p0_weights(lds, ws, KIN(3), KIN(4), KIN(5), KIN(21), KIN(22), KIN(23), KIN(7), KIN(12), KIN(14), KIN(19), KIN(6), KIN(20), KIN(11), KIN(13), gw, NGW, wave, lane, lo, hi, 0, 0, 0, 0); }
            }
#ifndef NO_GM
            if (ph == 4) gm::gmlp_phase(lds, Z, KIN(9), KIN(10), KIN(17), SS + 2 * MTOK, KIN(8), Yb, vcu, G, tid);
#endif
        } else if (ph == 0) {
            p0_weights(lds, ws, KIN(3), KIN(4), KIN(5), KIN(21), KIN(22), KIN(23), KIN(7), KIN(12), KIN(14), KIN(19), KIN(6), KIN(20), KIN(11), KIN(13), gw, NGW, wave, lane,
                       0, 2 * I_F, 3 * I_F, 5 * I_F, 6 * I_F, 6 * I_F + I_IN);
            p0_zero(ws, gw, NGW, lane);
            for (int m = gw; m < MTOK; m += NGW) rms_row_to_bf16(KIN(0) + (size_t)m * DM, KIN(2), XN + (size_t)m * DM, lane);
        } else if (ph == 5) {
            for (int m = gw; m < MTOK; m += 2 * NGW) qk_token2(m, (m + NGW < MTOK) ? m + NGW : m, (const int*)KIN(1), QRAW, KRAW, Z, KIN(15), KIN(16), Qb, Kb, lane);
        } else if (ph == 6) {
            for (int v = vcu; v < 256; v += G) { const int bh = v >> 1, s0 = (v & 1) * 2;
#pragma unroll 1
                for (int i = 0; i < 4; ++i) { const int qb = (i == 0) ? 7 - s0 : (i == 1) ? s0 : (i == 2) ? 6 - s0 : s0 + 1;
#ifndef NO_ATT
                    att::attn_unit(lds, Qb, Kb, VT, Yb, KIN(18), bh >> 3, bh & 7, qb, tid);
#endif
                } }
        }
        if (ph + 1 < a.ph_hi) { if (ph == 0) grid.sync(); else xcd_barrier(bar); }
#if DUP_MASK
        if (((DUP_MASK >> ph) & 1) && rep == 0) { rep = 1; if (ph + 1 >= a.ph_hi) grid.sync(); goto phase_again; }
#endif
    }
}

extern "C" void kernel_launch(void* const* d_in, const int* in_sizes, int n_in, void* d_out, int out_size, void* d_ws, size_t ws_size, hipStream_t stream) {
    static int grid = 0;
    if (grid == 0) {
        if (n_in != 24 || out_size != MTOK * DM || ws_size < WS_END) { fprintf(stderr, "kernel_launch: unexpected problem (n_in %d, out %d, ws %zu); nothing launched\n", n_in, out_size, ws_size); grid = -1; return; }
        int dev = 0, cus = 0, per_cu = 0;
        if (hipGetDevice(&dev) != hipSuccess || hipDeviceGetAttribute(&cus, hipDeviceAttributeMultiprocessorCount, dev) != hipSuccess) { grid = -1; return; }
        if (hipFuncSetAttribute((const void*)fwd_megakernel, hipFuncAttributeMaxDynamicSharedMemorySize, LDS_BYTES) != hipSuccess) { fprintf(stderr, "kernel_launch: hipFuncSetAttribute failed\n"); grid = -1; return; }
        if (hipOccupancyMaxActiveBlocksPerMultiprocessor(&per_cu, (const void*)fwd_megakernel, 512, LDS_BYTES) != hipSuccess || per_cu < 1) { fprintf(stderr, "kernel_launch: occupancy query says %d\n", per_cu); per_cu = 1; }
        (void)hipGetLastError();
        grid = cus * per_cu;
        if (grid % 8 != 0 || grid > 2048) grid = cus;
    }
    if (grid < 0) return;
    if (hipMemsetAsync((char*)d_ws + WS_BAR, 0, XCD_BAR_WORDS * 4, stream) != hipSuccess) { fprintf(stderr, "kernel_launch: memset of the barrier words failed\n"); return; }
    Args a{};
    for (int i = 0; i < 24; ++i) a.in[i] = (const float*)d_in[i];
    a.out = (float*)d_out; a.ws = (unsigned char*)d_ws;
#if MK_MULTI
    for (int ph = 0; ph < NPHASE; ++ph) { a.ph_lo = ph; a.ph_hi = ph + 1; hipLaunchKernelGGL(fwd_megakernel, dim3(grid), dim3(512), LDS_BYTES, stream, a); }
#else
    a.ph_lo = 0; a.ph_hi = NPHASE;
    void* args[] = {&a};
    hipError_t e = hipLaunchCooperativeKernel((const void*)fwd_megakernel, dim3(grid), dim3(512), args, LDS_BYTES, stream);
    if (e != hipSuccess) fprintf(stderr, "kernel_launch: cooperative launch failed: %s (grid %d)\n", hipGetErrorString(e), grid);
#endif
}
```
